# Optimizing an MI355X kernel written in HIP

```python
import jax, jax.numpy as jnp
from jax import lax
import numpy as np

D_MODEL = 2048
BATCH = 4
SEQ = 2048
DEPTH = 1

MEM_LEN = 256
EPS = 1e-6
D_FF = 5504
MLA_HEADS = 8
MLA_NOPE = 128
MLA_ROPE = 64
MLA_QK = MLA_NOPE + MLA_ROPE
MLA_V = 128
MLA_Q_RANK = 512
MLA_KV_RANK = 256
ROPE_BASE = 10000.0
Q_BLOCK = 128
HG_HEADS = 8
HG_DK = 128
HG_DV = 128
HG_CHUNK = 64
MLA_WIDTH = MLA_HEADS * MLA_V
HG_WIDTH = HG_HEADS * HG_DV
MIX_WIDTH = MLA_WIDTH + HG_WIDTH
HG_KW = HG_HEADS * HG_DK
IN_SIZES = (MLA_Q_RANK, MLA_KV_RANK, MLA_ROPE, HG_KW, HG_KW, HG_WIDTH, HG_WIDTH)
IN_COLS = int(sum(IN_SIZES))
IN_SPLITS = [int(v) for v in np.cumsum(IN_SIZES)[:-1]]
MEM_HEADS = 4
MEM_HD = 128
MEM_WIDTH = MEM_HEADS * MEM_HD

kernel_name = "hymba_mla_hgrn2_macaron_layer"


def rmsnorm(x, g):
    xf = x.astype(jnp.float32)
    y = xf * lax.rsqrt(jnp.mean(xf * xf, axis=-1, keepdims=True) + EPS)
    return (y * g.astype(jnp.float32)).astype(x.dtype)


def swiglu(h, w_gate, w_up, w_down):
    return (jax.nn.silu(h @ w_gate) * (h @ w_up)) @ w_down


def rope(x, positions):
    half = MLA_ROPE // 2
    inv_freq = ROPE_BASE ** (-jnp.arange(half, dtype=jnp.float32) / half)
    ang = positions.astype(jnp.float32)[..., None] * inv_freq
    cos = jnp.cos(ang)[:, :, None, :]
    sin = jnp.sin(ang)[:, :, None, :]
    xf = x.astype(jnp.float32)
    x1, x2 = xf[..., :half], xf[..., half:]
    out = jnp.concatenate([x1 * cos - x2 * sin, x2 * cos + x1 * sin], axis=-1)
    return out.astype(x.dtype)


def mla_group(cq, ckv, kpe, positions, q_a_norm, w_q_up, kv_a_norm, w_kv_up, q_norm, k_norm, out_norm):
    B, S, _ = cq.shape
    q = (rmsnorm(cq, q_a_norm) @ w_q_up).reshape(B, S, MLA_HEADS, MLA_QK)
    kv = (rmsnorm(ckv, kv_a_norm) @ w_kv_up).reshape(B, S, MLA_HEADS, MLA_NOPE + MLA_V)
    k_nope, v = kv[..., :MLA_NOPE], kv[..., MLA_NOPE:]
    k_pe = jnp.broadcast_to(kpe[:, :, None, :], (B, S, MLA_HEADS, MLA_ROPE))
    k = jnp.concatenate([k_nope, k_pe], axis=-1)
    q = rmsnorm(q, q_norm)
    k = rmsnorm(k, k_norm)
    q = jnp.concatenate([q[..., :MLA_NOPE], rope(q[..., MLA_NOPE:], positions)], axis=-1)
    k = jnp.concatenate([k[..., :MLA_NOPE], rope(k[..., MLA_NOPE:], positions)], axis=-1)
    scale = MLA_QK ** -0.5
    nb = S // Q_BLOCK
    qb = q.reshape(B, nb, Q_BLOCK, MLA_HEADS, MLA_QK).transpose(1, 0, 2, 3, 4)
    kpos = jnp.arange(S)

    def attend(args):
        qblk, i = args
        qpos = i * Q_BLOCK + jnp.arange(Q_BLOCK)
        s = jnp.einsum('bqhd,bkhd->bhqk', qblk, k, preferred_element_type=jnp.float32) * scale
        s = jnp.where(kpos[None, :] <= qpos[:, None], s, -jnp.inf)
        p = jax.nn.softmax(s, axis=-1).astype(v.dtype)
        return jnp.einsum('bhqk,bkhd->bqhd', p, v)

    o = lax.map(attend, (qb, jnp.arange(nb)))
    o = o.transpose(1, 0, 2, 3, 4).reshape(B, S, MLA_WIDTH)
    return rmsnorm(o, out_norm)


def hgrn2_group(qx, fx, ix, gx, lb, out_norm):
    B, S, _ = qx.shape
    dtype = qx.dtype
    lbf = lb.astype(jnp.float32)
    f = lbf + (1.0 - lbf) * jax.nn.sigmoid(fx.astype(jnp.float32))
    logf = jnp.log(f)
    kx = 1.0 - f
    nc = S // HG_CHUNK

    def heads(t, d):
        return t.astype(jnp.float32).reshape(B, nc, HG_CHUNK, HG_HEADS, d).transpose(1, 0, 3, 2, 4)

    q, k, lf, v = heads(qx, HG_DK), heads(kx, HG_DK), heads(logf, HG_DK), heads(ix, HG_DV)
    causal = jnp.tril(jnp.ones((HG_CHUNK, HG_CHUNK), dtype=bool))

    def step(state, inp):
        qc, kc, vc, lfc = inp
        b = jnp.cumsum(lfc, axis=2)
        o_inter = jnp.einsum('bhtk,bhkv->bhtv', qc * jnp.exp(b), state)
        diff = b[:, :, :, None, :] - b[:, :, None, :, :]
        decay = jnp.exp(jnp.where(causal[None, None, :, :, None], diff, -jnp.inf))
        a = jnp.einsum('bhtk,bhsk,bhtsk->bhts', qc, kc, decay)
        o = o_inter + jnp.einsum('bhts,bhsv->bhtv', a, vc)
        b_last = b[:, :, -1:, :]
        k_dec = kc * jnp.exp(b_last - b)
        new_state = jnp.exp(b_last[:, :, 0, :])[..., None] * state + jnp.einsum('bhsk,bhsv->bhkv', k_dec, vc)
        return new_state, o

    s0 = jnp.zeros((B, HG_HEADS, HG_DK, HG_DV), jnp.float32)
    _, o = lax.scan(step, s0, (q, k, v, lf))
    o = o.transpose(1, 0, 3, 2, 4).reshape(B, S, HG_HEADS, HG_DV)
    o = rmsnorm(o, out_norm) * jax.nn.silu(gx.astype(jnp.float32).reshape(B, S, HG_HEADS, HG_DV))
    return o.reshape(B, S, HG_WIDTH).astype(dtype)


def memory_xattn(h, m, w_q, w_kv, q_norm, k_norm, w_o):
    B, S, _ = h.shape
    M = m.shape[1]
    q = rmsnorm((h @ w_q).reshape(B, S, MEM_HEADS, MEM_HD), q_norm)
    kv = (m @ w_kv).reshape(B, M, MEM_HEADS, 2 * MEM_HD)
    k = rmsnorm(kv[..., :MEM_HD], k_norm)
    v = kv[..., MEM_HD:]
    s = jnp.einsum('bshd,bmhd->bhsm', q, k, preferred_element_type=jnp.float32) * (MEM_HD ** -0.5)
    p = jax.nn.softmax(s, axis=-1).astype(v.dtype)
    o = jnp.einsum('bhsm,bmhd->bshd', p, v).reshape(B, S, MEM_WIDTH)
    return o @ w_o


def setup_inputs(seed: int = 0) -> dict:
    key = jax.random.key(seed)
    ks = iter(jax.random.split(key, 40))
    f32 = jnp.float32

    def w(shape, fan_in):
        return jax.random.normal(next(ks), shape, f32) * (fan_in ** -0.5)

    def gain(shape):
        return 1.0 + 0.02 * jax.random.normal(next(ks), shape, f32)

    L = DEPTH
    x = jax.random.normal(next(ks), (BATCH, SEQ, D_MODEL), f32)
    mem = jax.random.normal(next(ks), (BATCH, MEM_LEN, D_MODEL), f32)
    offset = jax.random.randint(next(ks), (BATCH, 1), 0, 4096, dtype=jnp.int32)
    positions = offset + jnp.arange(SEQ, dtype=jnp.int32)[None, :]
    return {
        "x": x, "mem": mem, "positions": positions,
        "ffn1_norm": gain((L, D_MODEL)),
        "ffn1_w_gate": w((L, D_MODEL, D_FF), D_MODEL),
        "ffn1_w_up": w((L, D_MODEL, D_FF), D_MODEL),
        "ffn1_w_down": w((L, D_FF, D_MODEL), D_FF),
        "mix_norm": gain((L, D_MODEL)),
        "w_in": w((L, D_MODEL, IN_COLS), D_MODEL),
        "mla_q_a_norm": gain((L, MLA_Q_RANK)),
        "mla_w_q_up": w((L, MLA_Q_RANK, MLA_HEADS * MLA_QK), MLA_Q_RANK),
        "mla_kv_a_norm": gain((L, MLA_KV_RANK)),
        "mla_w_kv_up": w((L, MLA_KV_RANK, MLA_HEADS * (MLA_NOPE + MLA_V)), MLA_KV_RANK),
        "mla_q_norm": gain((L, MLA_QK)),
        "mla_k_norm": gain((L, MLA_QK)),
        "mla_out_norm": gain((L, MLA_WIDTH)),
        "hg_lb_logits": 0.1 * jax.random.normal(next(ks), (L + 1, HG_KW), f32),
        "hg_out_norm": gain((L, HG_DV)),
        "w_out": w((L, MIX_WIDTH, D_MODEL), MIX_WIDTH),
        "xattn_norm": gain((L, D_MODEL)),
        "mem_norm": gain((L, D_MODEL)),
        "xattn_w_q": w((L, D_MODEL, MEM_WIDTH), D_MODEL),
        "xattn_w_kv": w((L, D_MODEL, 2 * MEM_WIDTH), D_MODEL),
        "xattn_q_norm": gain((L, MEM_HD)),
        "xattn_k_norm": gain((L, MEM_HD)),
        "xattn_w_o": w((L, MEM_WIDTH, D_MODEL), MEM_WIDTH),
        "ffn2_norm": gain((L, D_MODEL)),
        "ffn2_w_gate": w((L, D_MODEL, D_FF), D_MODEL),
        "ffn2_w_up": w((L, D_MODEL, D_FF), D_MODEL),
        "ffn2_w_down": w((L, D_FF, D_MODEL), D_FF),
    }


def reference(x, mem, positions,
              ffn1_norm, ffn1_w_gate, ffn1_w_up, ffn1_w_down,
              mix_norm, w_in,
              mla_q_a_norm, mla_w_q_up, mla_kv_a_norm, mla_w_kv_up, mla_q_norm, mla_k_norm, mla_out_norm,
              hg_lb_logits, hg_out_norm,
              w_out,
              xattn_norm, mem_norm, xattn_w_q, xattn_w_kv, xattn_q_norm, xattn_k_norm, xattn_w_o,
              ffn2_norm, ffn2_w_gate, ffn2_w_up, ffn2_w_down):
    lb_all = jnp.cumsum(jax.nn.softmax(hg_lb_logits.astype(jnp.float32), axis=0), axis=0)
    for l in range(DEPTH):
        h = rmsnorm(x, ffn1_norm[l])
        x = x + 0.5 * swiglu(h, ffn1_w_gate[l], ffn1_w_up[l], ffn1_w_down[l])
        h = rmsnorm(x, mix_norm[l])
        proj = h @ w_in[l]
        cq, ckv, kpe, hq, hf, hi, hg = jnp.split(proj, IN_SPLITS, axis=-1)
        a = mla_group(cq, ckv, kpe, positions, mla_q_a_norm[l], mla_w_q_up[l], mla_kv_a_norm[l],
                      mla_w_kv_up[l], mla_q_norm[l], mla_k_norm[l], mla_out_norm[l])
        r = hgrn2_group(hq, hf, hi, hg, lb_all[l], hg_out_norm[l])
        x = x + jnp.concatenate([a, r], axis=-1) @ w_out[l]
        h = rmsnorm(x, xattn_norm[l])
        m = rmsnorm(mem, mem_norm[l])
        x = x + memory_xattn(h, m, xattn_w_q[l], xattn_w_kv[l], xattn_q_norm[l], xattn_k_norm[l], xattn_w_o[l])
        h = rmsnorm(x, ffn2_norm[l])
        x = x + 0.5 * swiglu(h, ffn2_w_gate[l], ffn2_w_up[l], ffn2_w_down[l])
    return x
```

```cpp
#include <hip/hip_runtime.h>
#include <cstdio>
#include <cstdint>
#include <cmath>

namespace nv {
constexpr int B = 4, S = 2048, D = 2048, M = B * S, DFF = 5504, MEML = 256, MM = B * MEML;
constexpr int INC = 4928;
constexpr float EPS = 1e-6f;

template <int MODE>
__global__ __launch_bounds__(256) void ngemm(const float* __restrict__ A, int lda, const float* __restrict__ Bm, int ldb, const float* __restrict__ B2,
                                             float* C, int ldc, const float* R, int ldr, float alpha, int Mr, int N, int K) {
  __shared__ float As[16][65];
  __shared__ float Bs[16][64];
  __shared__ float Bs2[16][64];
  const int tx = threadIdx.x & 15, ty = threadIdx.x >> 4;
  const int m0 = blockIdx.y * 64, n0 = blockIdx.x * 64;
  float acc[4][4], acc2[4][4];
#pragma unroll
  for (int i = 0; i < 4; ++i)
#pragma unroll
    for (int j = 0; j < 4; ++j) { acc[i][j] = 0.f; acc2[i][j] = 0.f; }
  for (int k0 = 0; k0 < K; k0 += 16) {
    for (int i = threadIdx.x; i < 1024; i += 256) { int m = i >> 4, k = i & 15; As[k][m] = A[(size_t)(m0 + m) * lda + k0 + k]; }
    for (int i = threadIdx.x; i < 1024; i += 256) { int k = i >> 6, n = i & 63; Bs[k][n] = Bm[(size_t)(k0 + k) * ldb + n0 + n]; if (MODE == 2) Bs2[k][n] = B2[(size_t)(k0 + k) * ldb + n0 + n]; }
    __syncthreads();
#pragma unroll
    for (int k = 0; k < 16; ++k) {
      float a[4], b[4], b2[4];
#pragma unroll
      for (int i = 0; i < 4; ++i) a[i] = As[k][ty * 4 + i];
#pragma unroll
      for (int j = 0; j < 4; ++j) { b[j] = Bs[k][tx * 4 + j]; if (MODE == 2) b2[j] = Bs2[k][tx * 4 + j]; }
#pragma unroll
      for (int i = 0; i < 4; ++i)
#pragma unroll
        for (int j = 0; j < 4; ++j) { acc[i][j] = fmaf(a[i], b[j], acc[i][j]); if (MODE == 2) acc2[i][j] = fmaf(a[i], b2[j], acc2[i][j]); }
    }
    __syncthreads();
  }
#pragma unroll
  for (int i = 0; i < 4; ++i)
#pragma unroll
    for (int j = 0; j < 4; ++j) {
      const int m = m0 + ty * 4 + i, n = n0 + tx * 4 + j;
      float v = acc[i][j];
      if (MODE == 1) v = R[(size_t)m * ldr + n] + alpha * v;
      if (MODE == 2) { float g = v; v = g / (1.f + expf(-g)) * acc2[i][j]; }
      C[(size_t)m * ldc + n] = v;
    }
}

__global__ __launch_bounds__(256) void nrms(const float* in, int ld_in, int seg_stride_in, const float* g, float* out, int ld_out, int seg_stride_out, int width) {
  const int row = blockIdx.x, seg = blockIdx.y;
  const float* p = in + (size_t)row * ld_in + seg * seg_stride_in;
  float* o = out + (size_t)row * ld_out + seg * seg_stride_out;
  __shared__ float red[256];
  float s = 0.f;
  for (int i = threadIdx.x; i < width; i += 256) { float v = p[i]; s += v * v; }
  red[threadIdx.x] = s; __syncthreads();
  for (int st = 128; st > 0; st >>= 1) { if (threadIdx.x < st) red[threadIdx.x] += red[threadIdx.x + st]; __syncthreads(); }
  const float rstd = 1.0f / sqrtf(red[0] / (float)width + EPS);
  for (int i = threadIdx.x; i < width; i += 256) o[i] = p[i] * rstd * g[i];
}

__global__ __launch_bounds__(64) void nq_final(float* Q, const float* qn, const int* pos) {
  const int row = blockIdx.x, h = blockIdx.y, l = threadIdx.x;
  float* p = Q + (size_t)row * 1536 + h * 192;
  float v0 = p[l], v1 = p[64 + l], v2 = p[128 + l];
  float s = v0 * v0 + v1 * v1 + v2 * v2;
  for (int o = 1; o < 64; o <<= 1) s += __shfl_xor(s, o);
  const float rstd = 1.0f / sqrtf(s / 192.f + EPS);
  v0 *= rstd * qn[l]; v1 *= rstd * qn[64 + l]; v2 *= rstd * qn[128 + l];
  const int i = l & 31;
  const float inv_freq = powf(10000.0f, -(float)i / 32.0f);
  const float ang = (float)pos[row] * inv_freq;
  const float c = cosf(ang), sn = sinf(ang);
  const float other = __shfl_xor(v2, 32);
  const float r = (l < 32) ? (v2 * c - other * sn) : (v2 * c + other * sn);
  p[l] = v0; p[64 + l] = v1; p[128 + l] = r;
}
__global__ __launch_bounds__(64) void nk_final(float* KV, const float* P, const float* kn, const int* pos, float* KR) {
  const int row = blockIdx.x, h = blockIdx.y, l = threadIdx.x;
  float* p = KV + (size_t)row * 2048 + h * 256;
  float v0 = p[l], v1 = p[64 + l], v2 = P[(size_t)row * INC + 768 + l];
  float s = v0 * v0 + v1 * v1 + v2 * v2;
  for (int o = 1; o < 64; o <<= 1) s += __shfl_xor(s, o);
  const float rstd = 1.0f / sqrtf(s / 192.f + EPS);
  v0 *= rstd * kn[l]; v1 *= rstd * kn[64 + l]; v2 *= rstd * kn[128 + l];
  const int i = l & 31;
  const float inv_freq = powf(10000.0f, -(float)i / 32.0f);
  const float ang = (float)pos[row] * inv_freq;
  const float c = cosf(ang), sn = sinf(ang);
  const float other = __shfl_xor(v2, 32);
  const float r = (l < 32) ? (v2 * c - other * sn) : (v2 * c + other * sn);
  p[l] = v0; p[64 + l] = v1; KR[((size_t)row * 8 + h) * 64 + l] = r;
}

template <int D1, int D2, int DV, bool CAUSAL>
__global__ __launch_bounds__(128) void nattn(const float* Q, int ldq, int qhs, const float* K1, int ldk1, int k1hs, const float* K2, int ldk2, int k2hs,
                                             const float* V, int ldv, int vhs, float* O, int ldo, int ohs, int Sq, int Sk, float scale) {
  const int q = blockIdx.x, h = blockIdx.y, b = blockIdx.z, t = threadIdx.x;
  __shared__ float qs[D1 + D2 + 1];
  __shared__ float sc[2048];
  __shared__ float red[128];
  const float* qp = Q + (size_t)(b * Sq + q) * ldq + h * qhs;
  for (int i = t; i < D1 + D2; i += 128) qs[i] = qp[i];
  __syncthreads();
  const int nk = CAUSAL ? (q + 1) : Sk;
  float mx = -INFINITY;
  for (int k = t; k < nk; k += 128) {
    const float* k1 = K1 + (size_t)(b * Sk + k) * ldk1 + h * k1hs;
    float s = 0.f;
    for (int d = 0; d < D1; ++d) s = fmaf(qs[d], k1[d], s);
    if (D2 > 0) { const float* k2 = K2 + (size_t)(b * Sk + k) * ldk2 + h * k2hs; for (int d = 0; d < D2; ++d) s = fmaf(qs[D1 + d], k2[d], s); }
    s *= scale; sc[k] = s; mx = fmaxf(mx, s);
  }
  red[t] = mx; __syncthreads();
  for (int st = 64; st > 0; st >>= 1) { if (t < st) red[t] = fmaxf(red[t], red[t + st]); __syncthreads(); }
  mx = red[0]; __syncthreads();
  float sm = 0.f;
  for (int k = t; k < nk; k += 128) { float p = expf(sc[k] - mx); sc[k] = p; sm += p; }
  red[t] = sm; __syncthreads();
  for (int st = 64; st > 0; st >>= 1) { if (t < st) red[t] += red[t + st]; __syncthreads(); }
  const float inv = 1.f / red[0];
  for (int d = t; d < DV; d += 128) {
    float o = 0.f;
    for (int k = 0; k < nk; ++k) o = fmaf(sc[k], V[(size_t)(b * Sk + k) * ldv + h * vhs + d], o);
    O[(size_t)(b * Sq + q) * ldo + h * ohs + d] = o * inv;
  }
}

__global__ __launch_bounds__(512) void nhgrn(const float* P, const float* lblog, const float* gn, float* R, int ldr) {
  const int b = blockIdx.x >> 3, h = blockIdx.x & 7, tid = threadIdx.x, v = tid & 127, kq = tid >> 7;
  __shared__ float fs[128], ks[128], qs[128], part[4][128], red[128];
  float st[32];
#pragma unroll
  for (int i = 0; i < 32; ++i) st[i] = 0.f;
  for (int t = 0; t < S; ++t) {
    const float* pr = P + (size_t)(b * S + t) * INC;
    if (tid < 128) {
      const int k = tid;
      const float l0 = lblog[h * 128 + k], l1 = lblog[1024 + h * 128 + k];
      const float mxl = fmaxf(l0, l1);
      const float e0 = expf(l0 - mxl), e1 = expf(l1 - mxl);
      const float lb = e0 / (e0 + e1);
      const float fx = pr[1856 + h * 128 + k];
      const float f = lb + (1.f - lb) * (1.f / (1.f + expf(-fx)));
      fs[k] = f; ks[k] = 1.f - f; qs[k] = pr[832 + h * 128 + k];
    }
    __syncthreads();
    const float vv = pr[2880 + h * 128 + v];
    float o = 0.f;
#pragma unroll
    for (int i = 0; i < 32; ++i) { const int k = kq * 32 + i; st[i] = fs[k] * st[i] + ks[k] * vv; o = fmaf(qs[k], st[i], o); }
    part[kq][v] = o;
    __syncthreads();
    if (tid < 128) {
      const float ot = part[0][v] + part[1][v] + part[2][v] + part[3][v];
      red[v] = ot * ot;
      part[0][v] = ot;
    }
    __syncthreads();
    if (tid < 64) red[tid] += red[tid + 64];
    __syncthreads();
    if (tid < 64) { float s = red[tid]; for (int o2 = 1; o2 < 64; o2 <<= 1) s += __shfl_xor(s, o2); if (tid == 0) red[0] = s; }
    __syncthreads();
    if (tid < 128) {
      const float rstd = 1.0f / sqrtf(red[0] / 128.f + EPS);
      const float gx = pr[3904 + h * 128 + v];
      R[(size_t)(b * S + t) * ldr + h * 128 + v] = part[0][v] * rstd * gn[v] * (gx / (1.f + expf(-gx)));
    }
    __syncthreads();
  }
}
}

static inline size_t al(size_t x) { return (x + 255) & ~(size_t)255; }

extern "C" void kernel_launch(void* const* d_in, const int* in_sizes, int n_in, void* d_out, int out_size, void* d_ws, size_t ws_size, hipStream_t stream) {
  using namespace nv;
  const float* x = (const float*)d_in[0]; const float* mem = (const float*)d_in[1]; const int* pos = (const int*)d_in[2];
  const float* f1n = (const float*)d_in[3]; const float* f1g = (const float*)d_in[4]; const float* f1u = (const float*)d_in[5]; const float* f1d = (const float*)d_in[6];
  const float* mixn = (const float*)d_in[7]; const float* win = (const float*)d_in[8];
  const float* qan = (const float*)d_in[9]; const float* wqup = (const float*)d_in[10]; const float* kvan = (const float*)d_in[11]; const float* wkvup = (const float*)d_in[12];
  const float* qn = (const float*)d_in[13]; const float* kn = (const float*)d_in[14]; const float* outn = (const float*)d_in[15];
  const float* lblog = (const float*)d_in[16]; const float* hgn = (const float*)d_in[17]; const float* wout = (const float*)d_in[18];
  const float* xan = (const float*)d_in[19]; const float* memn = (const float*)d_in[20]; const float* xwq = (const float*)d_in[21]; const float* xwkv = (const float*)d_in[22];
  const float* xqn = (const float*)d_in[23]; const float* xkn = (const float*)d_in[24]; const float* xwo = (const float*)d_in[25];
  const float* f2n = (const float*)d_in[26]; const float* f2g = (const float*)d_in[27]; const float* f2u = (const float*)d_in[28]; const float* f2d = (const float*)d_in[29];
  float* out = (float*)d_out;
  char* ws = (char*)d_ws;
  size_t off = 0;
  float* RA = (float*)(ws + off); off += al((size_t)M * INC * 4);
  float* RB = (float*)(ws + off); off += al((size_t)M * 2048 * 4);
  float* RC = (float*)(ws + off); off += al((size_t)M * 1536 * 4);
  float* RD = (float*)(ws + off); off += al((size_t)M * 2048 * 4);
  float* RE = (float*)(ws + off); off += al((size_t)M * 768 * 4);
  float* RF = (float*)(ws + off); off += al((size_t)M * 512 * 4);
  if (off > ws_size || n_in != 30) { fprintf(stderr, "naive: ws too small %zu > %zu\n", off, ws_size); return; }

  auto ffn = [&](const float* xin, const float* nrm, const float* wg, const float* wu, const float* wd, float* xout) {
    hipLaunchKernelGGL(nrms, dim3(M, 1), dim3(256), 0, stream, xin, D, 0, nrm, RB, D, 0, D);
    for (int half = 0; half < 2; ++half) {
      const int r0 = half * 4096;
      hipLaunchKernelGGL(ngemm<2>, dim3(DFF / 64, 4096 / 64), dim3(256), 0, stream, RB + (size_t)r0 * D, D, wg, DFF, wu, RA, DFF, (const float*)nullptr, 0, 0.f, 4096, DFF, D);
      hipLaunchKernelGGL(ngemm<1>, dim3(D / 64, 4096 / 64), dim3(256), 0, stream, RA, DFF, wd, D, (const float*)nullptr, xout + (size_t)r0 * D, D, xin + (size_t)r0 * D, D, 0.5f, 4096, D, DFF);
    }
  };
  ffn(x, f1n, f1g, f1u, f1d, out);
  hipLaunchKernelGGL(nrms, dim3(M, 1), dim3(256), 0, stream, out, D, 0, mixn, RB, D, 0, D);
  float* P = RA;
  hipLaunchKernelGGL(ngemm<0>, dim3(INC / 64, M / 64), dim3(256), 0, stream, RB, D, win, INC, (const float*)nullptr, P, INC, (const float*)nullptr, 0, 0.f, M, INC, D);
  float* CQN = RE; float* CKVN = RE + (size_t)M * 512;
  hipLaunchKernelGGL(nrms, dim3(M, 1), dim3(256), 0, stream, P, INC, 0, qan, CQN, 512, 0, 512);
  hipLaunchKernelGGL(nrms, dim3(M, 1), dim3(256), 0, stream, P + 512, INC, 0, kvan, CKVN, 256, 0, 256);
  float* Q = RC; float* KV = RD; float* KR = RF; float* MIX = RB;
  hipLaunchKernelGGL(ngemm<0>, dim3(1536 / 64, M / 64), dim3(256), 0, stream, CQN, 512, wqup, 1536, (const float*)nullptr, Q, 1536, (const float*)nullptr, 0, 0.f, M, 1536, 512);
  hipLaunchKernelGGL(ngemm<0>, dim3(2048 / 64, M / 64), dim3(256), 0, stream, CKVN, 256, wkvup, 2048, (const float*)nullptr, KV, 2048, (const float*)nullptr, 0, 0.f, M, 2048, 256);
  hipLaunchKernelGGL(nq_final, dim3(M, 8), dim3(64), 0, stream, Q, qn, pos);
  hipLaunchKernelGGL(nk_final, dim3(M, 8), dim3(64), 0, stream, KV, P, kn, pos, KR);
  hipLaunchKernelGGL((nattn<128, 64, 128, true>), dim3(S, 8, B), dim3(128), 0, stream, Q, 1536, 192, KV, 2048, 256, KR, 512, 64, KV + 128, 2048, 256, MIX, 2048, 128, S, S, 0.07216878364870322f);
  hipLaunchKernelGGL(nrms, dim3(M, 1), dim3(256), 0, stream, MIX, 2048, 0, outn, MIX, 2048, 0, 1024);
  hipLaunchKernelGGL(nhgrn, dim3(32), dim3(512), 0, stream, P, lblog, hgn, MIX + 1024, 2048);
  hipLaunchKernelGGL(ngemm<1>, dim3(D / 64, M / 64), dim3(256), 0, stream, MIX, 2048, wout, D, (const float*)nullptr, out, D, out, D, 1.0f, M, D, 2048);
  float* KVX = RE; float* MN = RE + (size_t)MM * 1024; float* XQ = RC; float* XO = RC + (size_t)M * 512;
  hipLaunchKernelGGL(nrms, dim3(M, 1), dim3(256), 0, stream, out, D, 0, xan, RB, D, 0, D);
  hipLaunchKernelGGL(nrms, dim3(MM, 1), dim3(256), 0, stream, mem, D, 0, memn, MN, D, 0, D);
  hipLaunchKernelGGL(ngemm<0>, dim3(512 / 64, M / 64), dim3(256), 0, stream, RB, D, xwq, 512, (const float*)nullptr, XQ, 512, (const float*)nullptr, 0, 0.f, M, 512, D);
  hipLaunchKernelGGL(ngemm<0>, dim3(1024 / 64, MM / 64), dim3(256), 0, stream, MN, D, xwkv, 1024, (const float*)nullptr, KVX, 1024, (const float*)nullptr, 0, 0.f, MM, 1024, D);
  hipLaunchKernelGGL(nrms, dim3(M, 4), dim3(256), 0, stream, XQ, 512, 128, xqn, XQ, 512, 128, 128);
  hipLaunchKernelGGL(nrms, dim3(MM, 4), dim3(256), 0, stream, KVX, 1024, 256, xkn, KVX, 1024, 256, 128);
  hipLaunchKernelGGL((nattn<128, 0, 128, false>), dim3(S, 4, B), dim3(128), 0, stream, XQ, 512, 128, KVX, 1024, 256, (const float*)nullptr, 0, 0, KVX + 128, 1024, 256, XO, 512, 128, S, MEML, 0.08838834764831845f);
  hipLaunchKernelGGL(ngemm<1>, dim3(D / 64, M / 64), dim3(256), 0, stream, XO, 512, xwo, D, (const float*)nullptr, out, D, out, D, 1.0f, M, D, 512);
  ffn(out, f2n, f2g, f2u, f2d, out);
}
```

```cpp
#include <hip/hip_runtime.h>
#include <cstdio>
#include <cstdint>
#include <cmath>

#ifndef MK_REP_PHASE
#define MK_REP_PHASE -1
#endif
#ifndef MK_REP_COUNT
#define MK_REP_COUNT 0
#endif
constexpr int NWAVES = 8;
constexpr int BATCH = 4, SEQ = 2048, DM = 2048, M = BATCH * SEQ, DFF = 5504, MEML = 256, MMEM = BATCH * MEML;
constexpr int INC = 4928, INCP = 5120;
constexpr int KVP = 2560;
constexpr float EPS = 1e-6f;
constexpr size_t MiB = 1u << 20;
constexpr size_t WS_CTL = 0, CTL_ZERO_BYTES = 256 * 1024;
constexpr size_t WS_LB = 1 * MiB, WS_ROPE = 2 * MiB, WS_KPE = 4 * MiB, WS_DV = 6 * MiB, WS_MEMN = 7 * MiB, WS_XKV = 11 * MiB;
constexpr size_t WS_WXQ = 13 * MiB, WS_WXKV = 15 * MiB, WS_WXO = 19 * MiB, WS_WQUP = 21 * MiB, WS_WKVUP = 23 * MiB, WS_WOUT = 25 * MiB, WS_WIN = 33 * MiB;
constexpr size_t WS_R1 = 53 * MiB;
constexpr size_t WS_WGU = WS_R1, WS_WD = WS_R1 + 43 * MiB, WS_QRAW = WS_R1, WS_KV = WS_R1 + 24 * MiB;
constexpr size_t WS_ACT = 118 * MiB;
constexpr size_t WS_HQ = WS_ACT, WS_LF = WS_ACT + 16 * MiB, WS_HI = WS_ACT + 48 * MiB, WS_HG = WS_ACT + 64 * MiB;
constexpr size_t WS_XB = 204 * MiB;
constexpr size_t WS_MIX = 236 * MiB, WS_CQ = WS_MIX, WS_CKV = WS_MIX + 8 * MiB;
constexpr size_t WS_DS = 268 * MiB, WS_XO = WS_DS + 8 * MiB, WS_XQP = WS_DS + 16 * MiB;
constexpr size_t WS_XQ_UNUSED = WS_DS;
constexpr size_t WS_W2GU = 332 * MiB, WS_W2D = 375 * MiB;
constexpr size_t WS_END = 397 * MiB;
constexpr int CW_BAR = 4096;
constexpr int CW_RS = 16384;
constexpr int RS_X1 = 0, RS_CQ = 1, RS_CKV = 2, RS_O = 3, RS_X2 = 4, RS_X3 = 5;
static_assert((CW_RS + 6 * M) * 4 <= (int)CTL_ZERO_BYTES, "CTL region");
constexpr int RING_BYTES = 131072, LDSCTL_OFF = RING_BYTES, MISC_OFF = LDSCTL_OFF + 320, LDS_BYTES = 147456;

__device__ __forceinline__ int lane_id() { int l; asm volatile("v_mbcnt_lo_u32_b32 %0, -1, 0\n\tv_mbcnt_hi_u32_b32 %0, -1, %0" : "=v"(l)); return l; }

namespace pg8 {
#define PG8_LAS __attribute__((address_space(3)))
typedef unsigned short bf16_t;
typedef short bf16x8 __attribute__((ext_vector_type(8)));
typedef float f32x4 __attribute__((ext_vector_type(4)));
typedef unsigned u32x4 __attribute__((ext_vector_type(4)));
constexpr int BM = 256, BK = 64, HALF = 128, HTB = HALF * BK * 2  , STAGE_BYTES = 8 * HTB, NXCD = 8, WGM = 8;

__host__ __device__ __forceinline__ int lds_byte(int r, int c) { const int st = (r >> 4) * 2 + (c >> 5), rr = r & 15, cc = c & 31, ob = rr * 64 + cc * 2; return st * 1024 + (ob ^ (((ob >> 9) & 1) << 5)); }
__host__ __device__ __forceinline__ void stage_rc(int b, int& R, int& C) { const int st = b / 1024, sb = b % 1024, swz = sb ^ (((sb >> 9) & 1) << 5); R = (st >> 1) * 16 + swz / 64; C = (st & 1) * 32 + (swz % 64) / 2; }
__host__ __device__ __forceinline__ int perm32(int rho) { const int n = rho >> 4, i = rho & 15; return 8 * (i >> 2) + 4 * n + (i & 3); }

struct Unit { int pm, pn, half; };
struct Gemm { const bf16_t* A; const bf16_t* Bt; int M, N, K, ld; };

struct StaticOrder {
    int nM, nN, nwg, G, c;
    __host__ __device__ void init(int M, int N, int G_, int c_) { nM = M / BM; nN = N / BM; nwg = nM * nN; G = G_; c = c_; }
    __host__ __device__ bool next(int i, Unit& u) const { return at((long)i * G + c, u); }
    __host__ __device__ bool at(long L, Unit& u) const {
        if (L >= nwg) return false;
        u.half = 0; int wgid = (int)L; { const int q = nwg / NXCD, r = nwg % NXCD, xcd = wgid % NXCD, off = wgid / NXCD; wgid = (xcd < r ? xcd * (q + 1) : r * (q + 1) + (xcd - r) * q) + off; }
        const int nig = WGM * nN, gid = wgid / nig, fm = gid * WGM, gsz = (nM - fm) < WGM ? (nM - fm) : WGM;
        u.pm = fm + ((wgid % nig) % gsz); u.pn = (wgid % nig) / gsz; return true;
    }
    __device__ __forceinline__ void a_ready(const Unit&) const {}
    __device__ __forceinline__ void done(const Unit&) const {}
};

struct HalfTailOrder : StaticOrder {
    __host__ __device__ bool next(int i, Unit& u) const {
        const int rounds = (nwg + G - 1) / G, rem = nwg - (rounds - 1) * G;
        if (rem < G && 2 * rem <= G && i == rounds - 1) { const int j = c >> 1; if (j >= rem) return false; if (!at((long)(rounds - 1) * G + j, u)) return false; u.half = 1 + (c & 1); return true; }
        return at((long)i * G + c, u);
    }
};


#define PG8_GAS __attribute__((address_space(1)))
__device__ __forceinline__ void atomic_addf(float* p, float v) { (void)__hip_atomic_fetch_add((PG8_GAS float*)p, v, __ATOMIC_RELAXED, __HIP_MEMORY_SCOPE_AGENT); }
typedef float f32x2_t __attribute__((ext_vector_type(2))); typedef __bf16 bf16x2_t __attribute__((ext_vector_type(2)));
__device__ __forceinline__ unsigned cvtpk(float lo, float hi) { f32x2_t v = {lo, hi}; bf16x2_t b = __builtin_convertvector(v, bf16x2_t); return __builtin_bit_cast(unsigned, b); }
__device__ __forceinline__ float fsigmoid(float x) { return __builtin_amdgcn_rcpf(1.0f + __builtin_amdgcn_exp2f(-1.4426950408889634f * x)); }
__device__ __forceinline__ float rstd_of(float ss, float inv_n) { return 1.0f / sqrtf(ss * inv_n + 1e-6f); }
__device__ __forceinline__ u32x4 pack8(const f32x4 a, const f32x4 b) { u32x4 w; w.x = cvtpk(a[0], a[1]); w.y = cvtpk(a[2], a[3]); w.z = cvtpk(b[0], b[1]); w.w = cvtpk(b[2], b[3]); return w; }
__device__ __forceinline__ float dot4(const f32x4 a) { return (a[0] * a[0] + a[1] * a[1]) + (a[2] * a[2] + a[3] * a[3]); }
constexpr float rs_div(int idx) { return (MK_REP_COUNT > 0 && ((idx == RS_X1 && MK_REP_PHASE == 2) || ((idx == RS_CQ || idx == RS_CKV) && MK_REP_PHASE == 3))) ? 1.0f / (1 + MK_REP_COUNT) : 1.0f; }
__device__ __forceinline__ float* rs_ptr(unsigned char* ws, int idx) { return (float*)(ws + WS_CTL) + CW_RS + idx * M; }
#define PG8_EPI_ENTER int fr = fr_, fq = fq_; unsigned char* w = ws; asm volatile("" : "+v"(fr), "+v"(fq), "+s"(w));

template <int RSI> struct EpiSwiglu {
    static constexpr bool PERM = true, AFTER_DRAIN = false;
    unsigned char* ws;
    __device__ __forceinline__ void operator()(const f32x4 (&acc)[2][2][4][2], const Unit& u, int wr, int wc, int fr_, int fq_) const {
        PG8_EPI_ENTER
        bf16_t* O = (bf16_t*)(w + WS_ACT); const float* rs = RSI >= 0 ? rs_ptr(w, RSI) : nullptr;
        const int row0 = u.pm * BM + (u.half == 2 ? HALF : 0) + wr * 64 + fr, col0 = u.pn * HALF + wc * 32 + 8 * fq;
#pragma unroll
        for (int ai = 0; ai < 2; ++ai)
#pragma unroll
            for (int m = 0; m < 4; ++m) {
                if (ai == 1 && u.half != 0) continue;
                const int row = row0 + ai * HALF + m * 16;
                const float sc = RSI >= 0 ? rstd_of(rs[row], rs_div(RSI) / DM) : 1.0f;
                f32x4 v[2];
#pragma unroll
                for (int n = 0; n < 2; ++n)
#pragma unroll
                    for (int i = 0; i < 4; ++i) { const float g = acc[ai][0][m][n][i] * sc, uu = acc[ai][1][m][n][i] * sc; v[n][i] = g * fsigmoid(g) * uu; }
                *(PG8_GAS u32x4*)(O + (size_t)row * DFF + col0) = pack8(v[0], v[1]);
            }
    }
};
template <int RSI, int ALPHA2, bool BASE_X, bool OUT_F32> struct EpiResid {
    static constexpr bool PERM = true, AFTER_DRAIN = false;
    unsigned char* ws; const float* x; float* out;
    __device__ __forceinline__ void operator()(const f32x4 (&acc)[2][2][4][2], const Unit& u, int wr, int wc, int fr_, int fq_) const {
        PG8_EPI_ENTER
        constexpr float alpha = 0.5f * ALPHA2;
        bf16_t* xb = (bf16_t*)(w + WS_XB); float* rs = rs_ptr(w, RSI >= 0 ? RSI : 0);
        const int row0 = u.pm * BM + wr * 64 + fr, col0 = u.pn * BM + wc * 32 + 8 * fq;
#pragma unroll
        for (int ai = 0; ai < 2; ++ai)
#pragma unroll
            for (int m = 0; m < 4; ++m) {
                const int row = row0 + ai * HALF + m * 16; const size_t off = (size_t)row * DM + col0; float ss = 0.f;
#pragma unroll
                for (int bj = 0; bj < 2; ++bj) {
                    f32x4 b0, b1;
                    if (BASE_X) { b0 = __builtin_nontemporal_load((const PG8_GAS f32x4*)(x + off + bj * HALF)); b1 = __builtin_nontemporal_load((const PG8_GAS f32x4*)(x + off + bj * HALF + 4)); }
                    else { const u32x4 bw = *(const PG8_GAS u32x4*)(xb + off + bj * HALF);
                        b0 = (f32x4){__uint_as_float(bw.x << 16), __uint_as_float(bw.x & 0xffff0000u), __uint_as_float(bw.y << 16), __uint_as_float(bw.y & 0xffff0000u)};
                        b1 = (f32x4){__uint_as_float(bw.z << 16), __uint_as_float(bw.z & 0xffff0000u), __uint_as_float(bw.w << 16), __uint_as_float(bw.w & 0xffff0000u)}; }
                    const f32x4 o0 = b0 + acc[ai][bj][m][0] * alpha, o1 = b1 + acc[ai][bj][m][1] * alpha;
                    if (OUT_F32) { *(PG8_GAS f32x4*)(out + off + bj * HALF) = o0; *(PG8_GAS f32x4*)(out + off + bj * HALF + 4) = o1; }
                    if (RSI >= 0) { ss += dot4(o0) + dot4(o1); *(PG8_GAS u32x4*)(xb + off + bj * HALF) = pack8(o0, o1); }
                }
                if (RSI >= 0) { ss += __shfl_xor(ss, 16); ss += __shfl_xor(ss, 32); if (fq == 0) atomic_addf(rs + row, ss); }
            }
    }
};
template <size_t O_OFF, int LDO, int RSI, int WIDTH> struct EpiScaleBf16 {
    static constexpr bool PERM = true, AFTER_DRAIN = false;
    unsigned char* ws;
    __device__ __forceinline__ void operator()(const f32x4 (&acc)[2][2][4][2], const Unit& u, int wr, int wc, int fr_, int fq_) const {
        PG8_EPI_ENTER
        bf16_t* O = (bf16_t*)(w + O_OFF); const float* rs = rs_ptr(w, RSI >= 0 ? RSI : 0);
        const int row0 = u.pm * BM + wr * 64 + fr, col0 = u.pn * BM + wc * 32 + 8 * fq;
#pragma unroll
        for (int ai = 0; ai < 2; ++ai)
#pragma unroll
            for (int m = 0; m < 4; ++m) {
                const int row = row0 + ai * HALF + m * 16;
                const float sc = RSI >= 0 ? rstd_of(rs[row], rs_div(RSI) / WIDTH) : 1.0f;
#pragma unroll
                for (int bj = 0; bj < 2; ++bj) *(PG8_GAS u32x4*)(O + (size_t)row * LDO + col0 + bj * HALF) = pack8(acc[ai][bj][m][0] * sc, acc[ai][bj][m][1] * sc);
            }
    }
};
template <size_t O_OFF, int LDO> struct EpiF32 {
    static constexpr bool PERM = true, AFTER_DRAIN = false;
    unsigned char* ws;
    __device__ __forceinline__ void operator()(const f32x4 (&acc)[2][2][4][2], const Unit& u, int wr, int wc, int fr_, int fq_) const {
        PG8_EPI_ENTER
        float* O = (float*)(w + O_OFF);
        const int row0 = u.pm * BM + wr * 64 + fr, col0 = u.pn * BM + wc * 32 + 8 * fq;
#pragma unroll
        for (int ai = 0; ai < 2; ++ai)
#pragma unroll
            for (int m = 0; m < 4; ++m) { const int row = row0 + ai * HALF + m * 16;
#pragma unroll
                for (int bj = 0; bj < 2; ++bj) { *(PG8_GAS f32x4*)(O + (size_t)row * LDO + col0 + bj * HALF) = acc[ai][bj][m][0]; *(PG8_GAS f32x4*)(O + (size_t)row * LDO + col0 + bj * HALF + 4) = acc[ai][bj][m][1]; } }
    }
};
struct EpiWin {
    static constexpr bool PERM = true, AFTER_DRAIN = false;
    unsigned char* ws;
    __device__ __forceinline__ void operator()(const f32x4 (&acc)[2][2][4][2], const Unit& u, int wr, int wc, int fr_, int fq_) const {
        PG8_EPI_ENTER
        const float* rs1 = rs_ptr(w, RS_X1); constexpr float inv_n = rs_div(RS_X1) / DM;
        const int row0 = u.pm * BM + wr * 64 + fr, cw = wc * 32 + 8 * fq, pn = u.pn;
        if (pn == 3) {
            float* KPE = (float*)(w + WS_KPE);
            if (wc < 2) {
#pragma unroll
                for (int ai = 0; ai < 2; ++ai)
#pragma unroll
                    for (int m = 0; m < 4; ++m) { const int row = row0 + ai * HALF + m * 16; const float sc = rstd_of(rs1[row], inv_n);
                        *(PG8_GAS f32x4*)(KPE + (size_t)row * 64 + cw) = acc[ai][0][m][0] * sc; *(PG8_GAS f32x4*)(KPE + (size_t)row * 64 + cw + 4) = acc[ai][0][m][1] * sc; }
            }
            return;
        }
        if (pn >= 8 && pn < 12) {
            float* LF = (float*)(w + WS_LF); const float* LB = (const float*)(w + WS_LB);
            const int cb = (pn - 8) * BM + cw;
            f32x4 lb[2][2];
#pragma unroll
            for (int bj = 0; bj < 2; ++bj)
#pragma unroll
                for (int n = 0; n < 2; ++n) lb[bj][n] = *(const PG8_GAS f32x4*)(LB + cb + bj * HALF + 4 * n);
#pragma unroll
            for (int ai = 0; ai < 2; ++ai)
#pragma unroll
                for (int m = 0; m < 4; ++m) { const int row = row0 + ai * HALF + m * 16; const float sc = rstd_of(rs1[row], inv_n);
#pragma unroll
                    for (int bj = 0; bj < 2; ++bj)
#pragma unroll
                        for (int n = 0; n < 2; ++n) { f32x4 o;
#pragma unroll
                            for (int i = 0; i < 4; ++i) { const float l = lb[bj][n][i]; const float f = l + (1.0f - l) * fsigmoid(acc[ai][bj][m][n][i] * sc); o[i] = __builtin_amdgcn_logf(f) * 0.6931471805599453f; }
                            *(PG8_GAS f32x4*)(LF + (size_t)row * 1024 + cb + bj * HALF + 4 * n) = o; } }
            return;
        }
        bf16_t* ob; int ldo, cb; float* rsq = nullptr;
        if (pn < 2) { ob = (bf16_t*)(w + WS_CQ); ldo = 512; cb = pn * BM; rsq = rs_ptr(w, RS_CQ); }
        else if (pn == 2) { ob = (bf16_t*)(w + WS_CKV); ldo = 256; cb = 0; rsq = rs_ptr(w, RS_CKV); }
        else if (pn < 8) { ob = (bf16_t*)(w + WS_HQ); ldo = 1024; cb = (pn - 4) * BM; }
        else if (pn < 16) { ob = (bf16_t*)(w + WS_HI); ldo = 1024; cb = (pn - 12) * BM; }
        else { ob = (bf16_t*)(w + WS_HG); ldo = 1024; cb = (pn - 16) * BM; }
#pragma unroll
        for (int ai = 0; ai < 2; ++ai)
#pragma unroll
            for (int m = 0; m < 4; ++m) { const int row = row0 + ai * HALF + m * 16; const float sc = rstd_of(rs1[row], inv_n); float ss = 0.f;
#pragma unroll
                for (int bj = 0; bj < 2; ++bj) { const f32x4 v0 = acc[ai][bj][m][0] * sc, v1 = acc[ai][bj][m][1] * sc; ss += dot4(v0) + dot4(v1);
                    *(PG8_GAS u32x4*)(ob + (size_t)row * ldo + cb + cw + bj * HALF) = pack8(v0, v1); }
                if (rsq) { ss += __shfl_xor(ss, 16); ss += __shfl_xor(ss, 32); if (fq == 0) atomic_addf(rsq + row, ss); } }
    }
};
struct MidScale {
    static constexpr bool ON = true; int t_at; unsigned char* ws;
    __device__ __forceinline__ void apply(f32x4 (&acc)[2][2][4][2], const Unit& u, int wr, int fr_) const {
        int fr = fr_; unsigned char* w = ws; asm volatile("" : "+v"(fr), "+s"(w));
        const float* rs = rs_ptr(w, RS_O);
#pragma unroll
        for (int ai = 0; ai < 2; ++ai)
#pragma unroll
            for (int m = 0; m < 4; ++m) { const float s = rstd_of(rs[u.pm * BM + ai * HALF + wr * 64 + m * 16 + fr], rs_div(RS_O) / 1024.0f);
#pragma unroll
                for (int bj = 0; bj < 2; ++bj)
#pragma unroll
                    for (int n = 0; n < 2; ++n) acc[ai][bj][m][n] *= s; }
    }
};

struct NoMid { static constexpr bool ON = false; int t_at; __device__ __forceinline__ void apply(f32x4 (&)[2][2][4][2], const Unit&, int, int) const {} };
template <class Epi, class Sched, bool ALIGN_EPI = false, bool SP2 = false, class Mid = NoMid, bool HALFU = false, int AUX_A = 0, int AUX_B = 0>
__device__ __forceinline__ void gemm_phase(PG8_LAS unsigned char* lds, const Gemm g, const Sched& S, const Epi& E, const int wave_, const Mid& Mh = Mid()) {
    int tid = wave_ * 64 + lane_id(); asm volatile("" : "+v"(tid));
    const int wid = wave_, lane = tid & 63, wr = wid >> 2, wc = wid & 3, fr = lane & 15, fq = lane >> 4;
    const int K = g.K, nt = K / BK, LD = g.ld ? g.ld : g.K;
    unsigned voffA[2], voffB[2];
#pragma unroll
    for (int i = 0; i < 2; ++i) { int R, C; stage_rc(tid * 16 + i * 8192, R, C); const int Rb = Epi::PERM ? ((R & ~31) + perm32(R & 31)) : R;
        voffA[i] = (unsigned)(R * LD + C) * 2u; voffB[i] = (unsigned)(Rb * LD + C) * 2u; }
    const size_t kstep = (size_t)(BK * 2);
    const size_t hstep = (size_t)HALF * LD * 2;
    const size_t tstep = 2 * hstep;
    const unsigned ldsw = (unsigned)wid * 1024u;
    const int aoff = lds_byte(wr * 64 + fr, fq * 8), boff = lds_byte(wc * 32 + fr, fq * 8);
#define PG8_SA(b, h) (((b) * 2 + (h)) * HTB)
#define PG8_SB(b, h) ((4 + (b) * 2 + (h)) * HTB)
#define PG8_STAGE(bufoff, gbase, voff) do { _Pragma("unroll") for (int _i = 0; _i < 2; ++_i) \
        __builtin_amdgcn_global_load_lds((const unsigned*)((const char*)(gbase) + (voff)[_i]), (PG8_LAS unsigned*)(lds + (bufoff) + ldsw + _i * 8192), 16, 0, (&(voff)[0] == &voffA[0]) ? AUX_A : AUX_B); } while (0)
#define PG8_LDA(dst, b, h) do { _Pragma("unroll") for (int m = 0; m < 4; ++m) _Pragma("unroll") for (int k = 0; k < 2; ++k) dst[m][k] = *(const PG8_LAS bf16x8*)(lds + PG8_SA(b, h) + aoff + m * 2048 + k * 1024); } while (0)
#define PG8_LDB(dst, b, h) do { _Pragma("unroll") for (int n = 0; n < 2; ++n) _Pragma("unroll") for (int k = 0; k < 2; ++k) dst[n][k] = *(const PG8_LAS bf16x8*)(lds + PG8_SB(b, h) + boff + n * 2048 + k * 1024); } while (0)
#define PG8_MMA(ai, bj, At, Bt) do { __builtin_amdgcn_s_setprio(1); _Pragma("unroll") for (int m = 0; m < 4; ++m) _Pragma("unroll") for (int n = 0; n < 2; ++n) _Pragma("unroll") for (int k = 0; k < 2; ++k) \
        acc[ai][bj][m][n] = __builtin_amdgcn_mfma_f32_16x16x32_bf16(Bt[n][k], At[m][k], acc[ai][bj][m][n], 0, 0, 0); __builtin_amdgcn_s_setprio(0); } while (0)
#define PG8_WAIT_V(n) asm volatile("s_waitcnt vmcnt(" #n ")" ::: "memory")
#define PG8_WAIT_L(n) asm volatile("s_waitcnt lgkmcnt(" #n ")" ::: "memory")
#define PG8_BAR __builtin_amdgcn_s_barrier()
#define PG8_SCHED __builtin_amdgcn_sched_barrier(0)
    Unit cur, nxt; int ui = 0;
    if (!S.next(0, cur)) return;
    f32x4 acc[2][2][4][2];
#pragma unroll
    for (int a = 0; a < 2; ++a)
#pragma unroll
        for (int b = 0; b < 2; ++b)
#pragma unroll
            for (int m = 0; m < 4; ++m)
#pragma unroll
                for (int n = 0; n < 2; ++n) acc[a][b][m][n] = (f32x4){0.f, 0.f, 0.f, 0.f};
    bf16x8 At[4][2], B0[2][2], B1[2][2];
    const char* cA = (const char*)g.A + (size_t)cur.pm * tstep; const char* cB = (const char*)g.Bt + (size_t)cur.pn * tstep;
    size_t hsA = hstep;
    if constexpr (HALFU) { if (cur.half) { hsA = 0; if (cur.half == 2) cA += hstep; } }
    S.a_ready(cur);
    if constexpr (SP2) {
        PG8_STAGE(PG8_SB(0, 0), cB, voffB); PG8_STAGE(PG8_SB(0, 1), cB + hstep, voffB); PG8_STAGE(PG8_SA(0, 0), cA, voffA); PG8_STAGE(PG8_SA(0, 1), cA + hsA, voffA);
        if (wr == 1) PG8_BAR;
        PG8_WAIT_V(2); PG8_BAR;
        PG8_STAGE(PG8_SB(1, 0), cB + kstep, voffB); PG8_STAGE(PG8_SA(1, 0), cA + kstep, voffA); PG8_STAGE(PG8_SB(1, 1), cB + hstep + kstep, voffB);
        PG8_WAIT_V(6); PG8_BAR;
    } else {
        PG8_STAGE(PG8_SB(0, 0), cB, voffB); PG8_STAGE(PG8_SA(0, 0), cA, voffA); PG8_STAGE(PG8_SB(0, 1), cB + hstep, voffB); PG8_STAGE(PG8_SA(0, 1), cA + hstep, voffA);
        if (wr == 1) PG8_BAR;
        PG8_WAIT_V(4); PG8_BAR;
        PG8_STAGE(PG8_SB(1, 0), cB + kstep, voffB); PG8_STAGE(PG8_SA(1, 0), cA + kstep, voffA); PG8_STAGE(PG8_SB(1, 1), cB + hstep + kstep, voffB);
        PG8_WAIT_V(6); PG8_BAR;
    }
    for (;;) {
        const bool has_next = S.next(ui + 1, nxt);
        const char* nA = has_next ? (const char*)g.A + (size_t)nxt.pm * tstep : cA; const char* nB = has_next ? (const char*)g.Bt + (size_t)nxt.pn * tstep : cB;
        size_t hsN = has_next ? hstep : hsA;
        if constexpr (HALFU) { if (has_next && nxt.half) { hsN = 0; if (nxt.half == 2) nA += hstep; } }
        const bool fullu = !HALFU || cur.half == 0;
        for (int t = 0; t < nt; t += 2) {
            if constexpr (Mid::ON) { if (t == Mh.t_at) Mh.apply(acc, cur, wr, fr); }
            const bool last = (t == nt - 2);
            const char* a1 = cA + (size_t)(t + 1) * kstep;
            const char* a2 = last ? nA : cA + (size_t)(t + 2) * kstep; const char* b2 = last ? nB : cB + (size_t)(t + 2) * kstep;
            const char* a3 = a2 + kstep; const char* b3 = b2 + kstep;
            if (last && has_next) S.a_ready(nxt);
            if constexpr (SP2) {
            PG8_LDB(B0, 0, 0); PG8_LDB(B1, 0, 1); PG8_SCHED; PG8_LDA(At, 0, 0); PG8_STAGE(PG8_SA(1, 1), a1 + hsA, voffA);
            PG8_WAIT_V(8); PG8_WAIT_L(0); PG8_BAR; PG8_MMA(0, 0, At, B0); PG8_MMA(0, 1, At, B1); PG8_BAR; PG8_SCHED;
            if (fullu) PG8_LDA(At, 0, 1); PG8_STAGE(PG8_SB(0, 0), b2, voffB); PG8_STAGE(PG8_SB(0, 1), b2 + hstep, voffB); PG8_STAGE(PG8_SA(0, 0), a2, voffA);
            PG8_WAIT_V(8); PG8_WAIT_L(0); PG8_BAR; if (fullu) { PG8_MMA(1, 0, At, B0); PG8_MMA(1, 1, At, B1); } PG8_BAR; PG8_SCHED;
            PG8_LDB(B0, 1, 0); PG8_LDB(B1, 1, 1); PG8_SCHED; PG8_LDA(At, 1, 0); PG8_STAGE(PG8_SA(0, 1), a2 + (last ? hsN : hsA), voffA);
            PG8_WAIT_V(8); PG8_WAIT_L(0); PG8_BAR; PG8_MMA(0, 0, At, B0); PG8_MMA(0, 1, At, B1); PG8_BAR; PG8_SCHED;
            if (fullu) PG8_LDA(At, 1, 1); PG8_STAGE(PG8_SB(1, 0), b3, voffB); PG8_STAGE(PG8_SB(1, 1), b3 + hstep, voffB); PG8_STAGE(PG8_SA(1, 0), a3, voffA);
            PG8_WAIT_V(8); PG8_WAIT_L(0); PG8_BAR; if (fullu) { PG8_MMA(1, 0, At, B0); PG8_MMA(1, 1, At, B1); } PG8_BAR; PG8_SCHED;
            } else {
            PG8_LDB(B0, 0, 0); PG8_SCHED; PG8_LDA(At, 0, 0); PG8_STAGE(PG8_SA(1, 1), a1 + hstep, voffA);
            PG8_WAIT_L(8); PG8_BAR; PG8_WAIT_L(0); PG8_MMA(0, 0, At, B0); PG8_BAR; PG8_SCHED;
            PG8_LDB(B1, 0, 1); PG8_STAGE(PG8_SB(0, 0), b2, voffB);
            PG8_BAR; PG8_WAIT_L(0); PG8_MMA(0, 1, At, B1); PG8_BAR;
            PG8_LDA(At, 0, 1); PG8_STAGE(PG8_SA(0, 0), a2, voffA);
            PG8_BAR; PG8_WAIT_L(0); PG8_MMA(1, 0, At, B0); PG8_BAR; PG8_SCHED;
            PG8_STAGE(PG8_SB(0, 1), b2 + hstep, voffB);
            PG8_WAIT_V(6); PG8_BAR; PG8_MMA(1, 1, At, B1); PG8_BAR;
            PG8_LDB(B0, 1, 0); PG8_SCHED; PG8_LDA(At, 1, 0); PG8_STAGE(PG8_SA(0, 1), a2 + hstep, voffA);
            PG8_WAIT_L(8); PG8_BAR; PG8_WAIT_L(0); PG8_MMA(0, 0, At, B0); PG8_BAR; PG8_SCHED;
            PG8_LDB(B1, 1, 1); PG8_STAGE(PG8_SB(1, 0), b3, voffB);
            PG8_BAR; PG8_WAIT_L(0); PG8_MMA(0, 1, At, B1); PG8_BAR;
            PG8_LDA(At, 1, 1); PG8_STAGE(PG8_SA(1, 0), a3, voffA);
            PG8_BAR; PG8_WAIT_L(0); PG8_MMA(1, 0, At, B0); PG8_BAR; PG8_SCHED;
            PG8_STAGE(PG8_SB(1, 1), b3 + hstep, voffB);
            PG8_WAIT_V(6); PG8_BAR; PG8_MMA(1, 1, At, B1); PG8_BAR;
            }
        }
        if constexpr (ALIGN_EPI) { if (wr == 0) PG8_BAR; }
        if constexpr (!Epi::AFTER_DRAIN) { E(acc, cur, wr, wc, fr, fq); S.done(cur); }
        if (!has_next) break;
#pragma unroll
        for (int a = 0; a < 2; ++a)
#pragma unroll
            for (int b = 0; b < 2; ++b)
#pragma unroll
                for (int m = 0; m < 4; ++m)
#pragma unroll
                    for (int n = 0; n < 2; ++n) acc[a][b][m][n] = (f32x4){0.f, 0.f, 0.f, 0.f};
        cur = nxt; cA = nA; cB = nB; hsA = hsN; ++ui;
        if constexpr (ALIGN_EPI) { if (wr == 1) PG8_BAR; }
    }
    PG8_WAIT_V(0);
    if constexpr (!ALIGN_EPI) { if (wr == 0) PG8_BAR; }
    PG8_BAR;
    if constexpr (Epi::AFTER_DRAIN) { E.fused(acc, cur, wr, wc, fr, fq, lds, wid, lane); S.done(cur); }
#undef PG8_SA
#undef PG8_SB
#undef PG8_STAGE
#undef PG8_LDA
#undef PG8_LDB
#undef PG8_MMA
#undef PG8_WAIT_V
#undef PG8_WAIT_L
#undef PG8_BAR
#undef PG8_SCHED
}
}


using pg8::cvtpk;
__device__ __forceinline__ float bflo(unsigned w) { return __uint_as_float(w << 16); }
__device__ __forceinline__ float bfhi(unsigned w) { return __uint_as_float(w & 0xffff0000u); }

namespace att {
using bf16 = unsigned short;
using bf16x8 = __attribute__((ext_vector_type(8))) short;
using s16x4  = __attribute__((ext_vector_type(4))) short;
using f32x16 = __attribute__((ext_vector_type(16))) float;
using f32x4  = __attribute__((ext_vector_type(4))) float;
using u32x4  = __attribute__((ext_vector_type(4))) unsigned;
using u32x2  = __attribute__((ext_vector_type(2))) unsigned;
constexpr int NW = 8, QBLK = 32, KVBLK = 64;
#define SBAR() __builtin_amdgcn_sched_barrier(0)
__device__ __forceinline__ int crow(int r, int hi) { return (r & 3) + 8 * (r >> 2) + 4 * hi; }
template <int DQK> __device__ __forceinline__ int kswz(int row, int colB) {
  if (DQK == 128) return row * 256 + (colB ^ ((row & 7) << 4));
  else return row * (DQK * 2 + 16) + colB;
}
template <class SC>
__device__ __forceinline__ void partialSM(f32x16& p0, f32x16& p1, float& m_reg, float& mn, float& alpha) {
  constexpr float SCALE = SC::S, THR = SC::T;
  constexpr float C = SCALE * 1.4426950408889634f;
  float pmax = p0[0];
#pragma unroll
  for (int r = 1; r < 16; ++r) pmax = fmaxf(pmax, p0[r]);
#pragma unroll
  for (int r = 0; r < 16; ++r) pmax = fmaxf(pmax, p1[r]);
  { auto rr = __builtin_amdgcn_permlane32_swap(__float_as_uint(pmax), __float_as_uint(pmax), false, false);
    pmax = fmaxf(__uint_as_float(rr[0]), __uint_as_float(rr[1])); }
  if (__builtin_expect(__all(pmax - m_reg <= THR / SCALE), 1)) { mn = m_reg; alpha = 1.f; }
  else { mn = fmaxf(m_reg, pmax); alpha = __builtin_amdgcn_exp2f((m_reg - mn) * C); m_reg = mn; }
  const float mnC = -mn * C;
#pragma unroll
  for (int r = 0; r < 16; ++r) p0[r] = fmaf(p0[r], C, mnC);
#pragma unroll
  for (int r = 0; r < 16; ++r) p1[r] = fmaf(p1[r], C, mnC);
#pragma unroll
  for (int r = 0; r < 16; ++r) p0[r] = __builtin_amdgcn_exp2f(p0[r]);
}
#define ATT_PK4(P, BASE, OUT) do { unsigned a0 = cvtpk(P[BASE + 0], P[BASE + 1]), a1 = cvtpk(P[BASE + 2], P[BASE + 3]);   \
    unsigned b0 = cvtpk(P[BASE + 4], P[BASE + 5]), b1 = cvtpk(P[BASE + 6], P[BASE + 7]);                              \
    auto r0 = __builtin_amdgcn_permlane32_swap(a0, b0, false, false); auto r1 = __builtin_amdgcn_permlane32_swap(a1, b1, false, false); \
    u32x4 w = {r0[0], r1[0], r0[1], r1[1]}; OUT = *reinterpret_cast<bf16x8*>(&w); } while (0)
__device__ __forceinline__ void pack_p(f32x16& p0, f32x16& p1, bf16x8& pa0, bf16x8& pa1, bf16x8& pa2, bf16x8& pa3) {
  ATT_PK4(p0, 0, pa0); ATT_PK4(p0, 8, pa1); ATT_PK4(p1, 0, pa2); ATT_PK4(p1, 8, pa3);
}
__device__ __forceinline__ void finishSM(f32x16& p0, f32x16& p1, float alpha, float& l_reg, bf16x8& pa0, bf16x8& pa1, bf16x8& pa2, bf16x8& pa3) {
#pragma unroll
  for (int r = 0; r < 16; ++r) p1[r] = __builtin_amdgcn_exp2f(p1[r]);
  float ps = 0;
#pragma unroll
  for (int r = 0; r < 16; ++r) ps += p0[r];
#pragma unroll
  for (int r = 0; r < 16; ++r) ps += p1[r];
  { auto rr = __builtin_amdgcn_permlane32_swap(__float_as_uint(ps), __float_as_uint(ps), false, false);
    ps = __uint_as_float(rr[0]) + __uint_as_float(rr[1]); }
  l_reg = l_reg * alpha + ps;
  pack_p(p0, p1, pa0, pa1, pa2, pa3);
}
template <int DQK> __device__ __forceinline__ void qkt(f32x16& p0, f32x16& p1, const char* Ks, const bf16x8* qr, int r32, int hi) {
  p0 = f32x16{}; p1 = f32x16{};
#pragma unroll
  for (int d0 = 0; d0 < DQK / 16; ++d0) { const int cb = (d0 * 16 + hi * 8) * 2;
    if (DQK > 128 && d0 > 0 && (d0 & 3) == 0) SBAR();
    const bf16x8 b0 = *reinterpret_cast<const bf16x8*>(Ks + kswz<DQK>(r32, cb));
    const bf16x8 b1 = *reinterpret_cast<const bf16x8*>(Ks + kswz<DQK>(32 + r32, cb));
    p0 = __builtin_amdgcn_mfma_f32_32x32x16_bf16(b0, qr[d0], p0, 0, 0, 0);
    p1 = __builtin_amdgcn_mfma_f32_32x32x16_bf16(b1, qr[d0], p1, 0, 0, 0); }
}
__device__ __forceinline__ int v_st(int k, int c) { const int kk = (k & ~0xC) | ((k & 4) << 1) | ((k & 8) >> 1); return ((kk >> 3) * 4 + (c >> 5)) * 512 + ((kk & 7) * 32 + (c & 31)) * 2; }
__device__ __forceinline__ int v_rd_base(int lane) { return ((lane & 3) << 3) | (((lane >> 2) & 3) << 6) | (((lane >> 4) & 1) << 5) | (((lane >> 5) & 1) << 8); }
constexpr int v_rd_off(int d0, int ks, int half) { return d0 * 512 + ks * 4096 + half * 2048; }
template <int OFF> __device__ __forceinline__ s16x4 tr_read(int vb) {
  s16x4 r; asm volatile("ds_read_b64_tr_b16 %0, %1 offset:%2" : "=&v"(r) : "v"(vb), "i"(OFF) : "memory"); return r;
}
#define ATT_PK(L, H) (bf16x8){L[0], L[1], L[2], L[3], H[0], H[1], H[2], H[3]}
template <int D0> __device__ __forceinline__ void pv_one(f32x16& od, int vb, bf16x8 pa0, bf16x8 pa1, bf16x8 pa2, bf16x8 pa3) {
  const s16x4 l0 = tr_read<v_rd_off(D0, 0, 0)>(vb), h0 = tr_read<v_rd_off(D0, 0, 1)>(vb), l1 = tr_read<v_rd_off(D0, 1, 0)>(vb), h1 = tr_read<v_rd_off(D0, 1, 1)>(vb);
  const s16x4 l2 = tr_read<v_rd_off(D0, 2, 0)>(vb), h2 = tr_read<v_rd_off(D0, 2, 1)>(vb), l3 = tr_read<v_rd_off(D0, 3, 0)>(vb), h3 = tr_read<v_rd_off(D0, 3, 1)>(vb);
  asm volatile("s_waitcnt lgkmcnt(0)" ::: "memory"); SBAR();
  od = __builtin_amdgcn_mfma_f32_32x32x16_bf16(pa0, ATT_PK(l0, h0), od, 0, 0, 0);
  od = __builtin_amdgcn_mfma_f32_32x32x16_bf16(pa1, ATT_PK(l1, h1), od, 0, 0, 0);
  od = __builtin_amdgcn_mfma_f32_32x32x16_bf16(pa2, ATT_PK(l2, h2), od, 0, 0, 0);
  od = __builtin_amdgcn_mfma_f32_32x32x16_bf16(pa3, ATT_PK(l3, h3), od, 0, 0, 0);
}
__device__ __forceinline__ void pv_d0(f32x16* o, int vb, bf16x8 pa0, bf16x8 pa1, bf16x8 pa2, bf16x8 pa3) {
  pv_one<0>(o[0], vb, pa0, pa1, pa2, pa3); pv_one<1>(o[1], vb, pa0, pa1, pa2, pa3); pv_one<2>(o[2], vb, pa0, pa1, pa2, pa3); pv_one<3>(o[3], vb, pa0, pa1, pa2, pa3);
}
__device__ __forceinline__ void cmask(f32x16& p0, f32x16& p1, int jb, int qrel, int hi) {
  const float NEG = -INFINITY; const int kb = 64 * jb + 4 * hi;
#pragma unroll
  for (int r = 0; r < 16; ++r) { const int kv = kb + (r & 3) + 8 * (r >> 2); if (kv > qrel) p0[r] = NEG; if (kv + 32 > qrel) p1[r] = NEG; }
}
struct ScaleMLA { static constexpr float S = 0.07216878364870322f; static constexpr float T = 8.f; };
struct ScaleX   { static constexpr float S = 0.08838834764831845f; static constexpr float T = 8.f; };

template <int DQK, int LDQ, int LDK, int LDO, bool CAUSAL, bool QNORM, bool ROWSQ, int SDEPTH, class SC>
__device__ __forceinline__ void attn_body(const float* __restrict__ Qb, const bf16* __restrict__ Kh, const bf16* __restrict__ Vh, bf16* __restrict__ Ob, int seq,
                                          const float* __restrict__ qg, float* rs, const int wave_, char* lds) {
  constexpr int ND = DQK / 16, NKC = DQK / 8, KCH = (64 * NKC) / 512;
  constexpr int SHM_V = KVBLK * 128 * 2, SHM_K = KVBLK * (DQK == 128 ? 256 : DQK * 2 + 16);
  int tid = wave_ * 64 + lane_id(); asm volatile("" : "+v"(tid));
  const int wid = wave_, lane = tid & 63, r32 = lane & 31, hi = lane >> 5;
  char* V_lds = lds; char* K_lds = lds + 2 * SHM_V;
  float* ws = (float*)(lds + 2 * SHM_V + 2 * SHM_K) + wid * 64; float* li_l = ws; float* al_l = ws + 32;
  float m_reg = -1e30f, l_reg = 0; f32x16 o[4] = {}; bf16x8 qr[ND];
  {
    static_assert(QNORM, "attn_body: f32 partial q rows + per-head norm");
    const float* Qw = Qb + (long)(wid * QBLK + r32) * LDQ + hi * 8; constexpr long PST = (long)8192 * LDQ;
    f32x4 qa[ND][2]; float ss = 0.f;
#pragma unroll
    for (int d0 = 0; d0 < ND; ++d0) { qa[d0][0] = *(const f32x4*)(Qw + d0 * 16) + *(const f32x4*)(Qw + PST + d0 * 16); qa[d0][1] = *(const f32x4*)(Qw + d0 * 16 + 4) + *(const f32x4*)(Qw + PST + d0 * 16 + 4);
#pragma unroll
      for (int j = 0; j < 4; ++j) ss += qa[d0][0][j] * qa[d0][0][j] + qa[d0][1][j] * qa[d0][1][j]; }
    { auto rr = __builtin_amdgcn_permlane32_swap(__float_as_uint(ss), __float_as_uint(ss), false, false); ss = __uint_as_float(rr[0]) + __uint_as_float(rr[1]); }
    const float rstd = 1.0f / sqrtf(ss * (1.0f / 128.0f) + 1e-6f);
#pragma unroll
    for (int d0 = 0; d0 < ND; ++d0) { const f32x4 g0 = *(const f32x4*)(qg + d0 * 16 + hi * 8), g1 = *(const f32x4*)(qg + d0 * 16 + hi * 8 + 4);
      u32x4 y; y[0] = cvtpk(qa[d0][0][0] * rstd * g0[0], qa[d0][0][1] * rstd * g0[1]); y[1] = cvtpk(qa[d0][0][2] * rstd * g0[2], qa[d0][0][3] * rstd * g0[3]);
      y[2] = cvtpk(qa[d0][1][0] * rstd * g1[0], qa[d0][1][1] * rstd * g1[1]); y[3] = cvtpk(qa[d0][1][2] * rstd * g1[2], qa[d0][1][3] * rstd * g1[3]);
      qr[d0] = *reinterpret_cast<bf16x8*>(&y); }
  }
  const int sr = tid >> 4, sc = (tid & 15) * 8, vst0 = v_st(sr, sc), vst1 = v_st(32 + sr, sc);
  int krow[KCH], kcc[KCH];
#pragma unroll
  for (int i = 0; i < KCH; ++i) { const int c = tid + 512 * i; krow[i] = c / NKC; kcc[i] = c % NKC; }
  const int vb0 = (int)(uintptr_t)V_lds + v_rd_base(lane);
  struct { bf16x8 vs0, vs1, ks[KCH]; } sr_[SDEPTH];
#define SLOAD(i, k0) do { sr_[i].vs0 = *reinterpret_cast<const bf16x8*>(&Vh[(long)((k0) + sr) * LDK + sc]); sr_[i].vs1 = *reinterpret_cast<const bf16x8*>(&Vh[(long)((k0) + 32 + sr) * LDK + sc]); \
    _Pragma("unroll") for (int q_ = 0; q_ < KCH; ++q_) sr_[i].ks[q_] = *reinterpret_cast<const bf16x8*>(&Kh[(long)((k0) + krow[q_]) * LDK + kcc[q_] * 8]); } while (0)
#define SWRITE(b, i) do { *(bf16x8*)(V_lds + (b) * SHM_V + vst0) = sr_[i].vs0; *(bf16x8*)(V_lds + (b) * SHM_V + vst1) = sr_[i].vs1; \
    _Pragma("unroll") for (int q_ = 0; q_ < KCH; ++q_) *(bf16x8*)(K_lds + (b) * SHM_K + kswz<DQK>(krow[q_], kcc[q_] * 16)) = sr_[i].ks[q_]; } while (0)
#define SWAIT() do { if constexpr (SDEPTH == 2) asm volatile("s_waitcnt vmcnt(4)" ::: "memory"); else asm volatile("s_waitcnt vmcnt(0)" ::: "memory"); } while (0)
#define RESC(a) do { if (__any((a) < 1.f)) { if (hi == 0) al_l[r32] = (a); asm volatile("s_waitcnt lgkmcnt(0)" ::: "memory"); \
    _Pragma("unroll") for (int d = 0; d < 4; ++d) _Pragma("unroll") for (int r = 0; r < 16; ++r) o[d][r] *= al_l[crow(r, hi)]; } } while (0)
  f32x16 pA0, pA1, pB0, pB1; float mnA, mnB, alA, alB; bf16x8 pa0, pa1, pa2, pa3; const int NT = seq / KVBLK;
  const int qrel = wid * QBLK + r32;
#define CMASK(P0, P1, t) do { if constexpr (CAUSAL) { const int jb_ = (t) - (NT - 4); if (jb_ >= 0) cmask(P0, P1, jb_, qrel, hi); } } while (0)
  constexpr int SE = 0, SO = SDEPTH - 1;
  SLOAD(SE, 0); asm volatile("s_waitcnt vmcnt(0)" ::: "memory"); SWRITE(0, SE); __syncthreads();
  qkt<DQK>(pA0, pA1, K_lds, qr, r32, hi); CMASK(pA0, pA1, 0); partialSM<SC>(pA0, pA1, m_reg, mnA, alA);
  SLOAD(SO, KVBLK); if constexpr (SDEPTH == 2) { if (2 < NT) SLOAD(SE, 2 * KVBLK); }
  SWAIT(); SWRITE(1, SO); __syncthreads();
  for (int j = 1; j + 1 < NT; j += 2) {
    SBAR(); qkt<DQK>(pB0, pB1, K_lds + SHM_K, qr, r32, hi); CMASK(pB0, pB1, j);
    finishSM(pA0, pA1, alA, l_reg, pa0, pa1, pa2, pa3); SBAR();
    SLOAD(SO, (j + SDEPTH) * KVBLK); SBAR();
    pv_d0(o, vb0, pa0, pa1, pa2, pa3); partialSM<SC>(pB0, pB1, m_reg, mnB, alB);
    __syncthreads(); SWAIT(); SWRITE(0, SE);
    RESC(alB); __syncthreads();
    SBAR(); qkt<DQK>(pA0, pA1, K_lds, qr, r32, hi); CMASK(pA0, pA1, j + 1);
    finishSM(pB0, pB1, alB, l_reg, pa0, pa1, pa2, pa3); SBAR();
    if (SDEPTH == 1 || j + 3 < NT) SLOAD(SE, (j + 1 + SDEPTH) * KVBLK); SBAR();
    pv_d0(o, vb0 + SHM_V, pa0, pa1, pa2, pa3); partialSM<SC>(pA0, pA1, m_reg, mnA, alA);
    __syncthreads(); SWAIT(); SWRITE(1, SO);
    RESC(alA); __syncthreads();
  }
  SBAR(); qkt<DQK>(pB0, pB1, K_lds + SHM_K, qr, r32, hi); CMASK(pB0, pB1, NT - 1);
  finishSM(pA0, pA1, alA, l_reg, pa0, pa1, pa2, pa3); SBAR();
  pv_d0(o, vb0, pa0, pa1, pa2, pa3); partialSM<SC>(pB0, pB1, m_reg, mnB, alB);
  __syncthreads(); RESC(alB);
  finishSM(pB0, pB1, alB, l_reg, pa0, pa1, pa2, pa3); SBAR();
  pv_d0(o, vb0 + SHM_V, pa0, pa1, pa2, pa3);
  if (hi == 0) li_l[r32] = l_reg; asm volatile("s_waitcnt lgkmcnt(0)" ::: "memory");
  float rli[16];
#pragma unroll
  for (int r = 0; r < 16; ++r) rli[r] = __builtin_amdgcn_rcpf(li_l[crow(r, hi)]);
  bf16* Ow = Ob + (long)(wid * QBLK) * LDO;
#pragma unroll
  for (int r = 0; r < 16; ++r) { const int orow = crow(r, hi); float ssr = 0.f;
#pragma unroll
    for (int d0 = 0; d0 < 4; ++d0) { const float v = o[d0][r] * rli[r]; ssr += v * v; Ow[(long)orow * LDO + d0 * 32 + r32] = (bf16)(cvtpk(v, 0.f) & 0xffffu); }
    if constexpr (ROWSQ) {
      ssr += __shfl_xor(ssr, 1); ssr += __shfl_xor(ssr, 2); ssr += __shfl_xor(ssr, 4); ssr += __shfl_xor(ssr, 8); ssr += __shfl_xor(ssr, 16);
      if (r32 == 0) pg8::atomic_addf(rs + wid * QBLK + orow, ssr);
    } }
  __syncthreads();
#undef SLOAD
#undef SWRITE
#undef SWAIT
#undef RESC
#undef CMASK
}

template <int DQK, int LDQ, int LDK, bool CAUSAL, class SC>
__device__ __forceinline__ void attn_body_s(const bf16* __restrict__ Qb, const bf16* __restrict__ Kh, const bf16* __restrict__ Vh, bf16* __restrict__ Ob, int ldo, int seq, int t_begin, int t_end, float* ml, int ml_stride, const int wave_, char* lds) {
  constexpr int ND = DQK / 16, NKC = DQK / 8, KCH = (64 * NKC) / 512;
  constexpr int SHM_V = KVBLK * 128 * 2, SHM_K = KVBLK * (DQK == 128 ? 256 : DQK * 2 + 16);
  int tid = wave_ * 64 + lane_id(); asm volatile("" : "+v"(tid));
  const int wid = wave_, lane = tid & 63, r32 = lane & 31, hi = lane >> 5;
  char* V_lds = lds; char* K_lds = lds + 2 * SHM_V;
  float* ws = (float*)(lds + 2 * SHM_V + 2 * SHM_K) + wid * 64; float* li_l = ws; float* al_l = ws + 32;
  constexpr int NDR = ND > 8 ? 8 : ND;
  char* Qs = lds + 2 * SHM_V + 2 * SHM_K + 2048 + wid * ((ND - NDR) * 1024) + lane * 16;
  float m_reg = -1e30f, l_reg = 0; f32x16 o[4] = {}; bf16x8 qr[NDR];
  const bf16* Qw = Qb + (long)(wid * QBLK + r32) * LDQ + hi * 8;
#pragma unroll
  for (int d0 = 0; d0 < NDR; ++d0) qr[d0] = *reinterpret_cast<const bf16x8*>(Qw + d0 * 16);
#pragma unroll
  for (int d0 = NDR; d0 < ND; ++d0) *(bf16x8*)(Qs + (d0 - NDR) * 1024) = *reinterpret_cast<const bf16x8*>(Qw + d0 * 16);
  const int sr = tid >> 4, sc = (tid & 15) * 8, vst0 = v_st(sr, sc), vst1 = v_st(32 + sr, sc);
  int krow[KCH], kcc[KCH];
#pragma unroll
  for (int i = 0; i < KCH; ++i) { const int c = tid + 512 * i; krow[i] = c / NKC; kcc[i] = c % NKC; }
  const int vb0 = (int)(uintptr_t)V_lds + v_rd_base(lane);
  bf16x8 vs0, vs1, ks[KCH];
  unsigned koff[KCH]; const unsigned voff0 = (unsigned)(sr * LDK + sc) * 2u, voff1 = (unsigned)((32 + sr) * LDK + sc) * 2u;
#pragma unroll
  for (int i = 0; i < KCH; ++i) koff[i] = (unsigned)(krow[i] * LDK + kcc[i] * 8) * 2u;
#define SLOAD(k0) do { const char* Kt_ = (const char*)Kh + (size_t)(k0) * (LDK * 2); const char* Vt_ = (const char*)Vh + (size_t)(k0) * (LDK * 2); \
    vs0 = *reinterpret_cast<const bf16x8*>(Vt_ + voff0); vs1 = *reinterpret_cast<const bf16x8*>(Vt_ + voff1); \
    _Pragma("unroll") for (int q_ = 0; q_ < KCH; ++q_) ks[q_] = *reinterpret_cast<const bf16x8*>(Kt_ + koff[q_]); } while (0)
#define SWRITE(b) do { *(bf16x8*)(V_lds + (b) * SHM_V + vst0) = vs0; *(bf16x8*)(V_lds + (b) * SHM_V + vst1) = vs1; \
    _Pragma("unroll") for (int q_ = 0; q_ < KCH; ++q_) *(bf16x8*)(K_lds + (b) * SHM_K + kswz<DQK>(krow[q_], kcc[q_] * 16)) = ks[q_]; } while (0)
  const int NT = seq / KVBLK; const int qrel = wid * QBLK + r32;
  SLOAD(t_begin * KVBLK); asm volatile("s_waitcnt vmcnt(0)" ::: "memory"); SWRITE(0); __syncthreads();
  for (int j = t_begin; j < t_end; ++j) {
    const int bsel = (j - t_begin) & 1;
    if (j + 1 < t_end) SLOAD((j + 1) * KVBLK);
    f32x16 p0, p1; float mn, al; bf16x8 pa0, pa1, pa2, pa3;
    SBAR();
    { const char* Ks = K_lds + bsel * SHM_K; p0 = f32x16{}; p1 = f32x16{};
#pragma unroll
      for (int d0 = 0; d0 < ND; ++d0) { const int cb = (d0 * 16 + hi * 8) * 2;
        const bf16x8 b0 = *reinterpret_cast<const bf16x8*>(Ks + kswz<DQK>(r32, cb)), b1 = *reinterpret_cast<const bf16x8*>(Ks + kswz<DQK>(32 + r32, cb));
        bf16x8 qf; if (d0 < NDR) qf = qr[d0 < NDR ? d0 : 0]; else qf = *(const bf16x8*)(Qs + (d0 - NDR) * 1024);
        p0 = __builtin_amdgcn_mfma_f32_32x32x16_bf16(b0, qf, p0, 0, 0, 0);
        p1 = __builtin_amdgcn_mfma_f32_32x32x16_bf16(b1, qf, p1, 0, 0, 0); } }
    if constexpr (CAUSAL) { const int jb_ = j - (NT - 4); if (jb_ >= 0) cmask(p0, p1, jb_, qrel, hi); }
    partialSM<SC>(p0, p1, m_reg, mn, al);
    if (__any(al < 1.f)) { if (hi == 0) al_l[r32] = al; asm volatile("s_waitcnt lgkmcnt(0)" ::: "memory");
#pragma unroll
      for (int d = 0; d < 4; ++d)
#pragma unroll
        for (int r = 0; r < 16; ++r) o[d][r] *= al_l[crow(r, hi)]; }
    finishSM(p0, p1, al, l_reg, pa0, pa1, pa2, pa3); SBAR();
    pv_d0(o, vb0 + bsel * SHM_V, pa0, pa1, pa2, pa3);
    if (j + 1 < t_end) { asm volatile("s_waitcnt vmcnt(0)" ::: "memory"); SWRITE(bsel ^ 1); }
    __syncthreads();
  }
  if (hi == 0) { li_l[r32] = l_reg; ml[(long)(wid * QBLK + r32) * ml_stride] = m_reg; ml[(long)(wid * QBLK + r32) * ml_stride + 1] = l_reg; }
  asm volatile("s_waitcnt lgkmcnt(0)" ::: "memory");
  float rli[16];
#pragma unroll
  for (int r = 0; r < 16; ++r) { const float lv = li_l[crow(r, hi)]; rli[r] = lv > 0.f ? __builtin_amdgcn_rcpf(lv) : 0.f; }
  bf16* Ow = Ob + (long)(wid * QBLK) * ldo;
#pragma unroll
  for (int r = 0; r < 16; ++r) { const int orow = crow(r, hi);
#pragma unroll
    for (int d0 = 0; d0 < 4; ++d0) Ow[(long)orow * ldo + d0 * 32 + r32] = (bf16)(cvtpk(o[d0][r] * rli[r], 0.f) & 0xffffu); }
  __syncthreads();
#undef SLOAD
#undef SWRITE
}
template <int DQK, int LDQ, int LDK, bool CAUSAL, class SC>
__device__ __forceinline__ void attn_body_p(const bf16* __restrict__ Qb, const bf16* __restrict__ Kh, const bf16* __restrict__ Vh, bf16* __restrict__ Ob, int ldo, int seq, int t_begin, int t_end, float* ml, int ml_stride, const int wave_, char* lds) {
  constexpr int ND = DQK / 16, NKC = DQK / 8, KCH = (64 * NKC) / 512, NDR = ND > 8 ? 8 : ND;
  constexpr int SHM_V = KVBLK * 128 * 2, SHM_K = KVBLK * (DQK == 128 ? 256 : DQK * 2 + 16);
  int tid = wave_ * 64 + lane_id(); asm volatile("" : "+v"(tid));
  const int wid = wave_, lane = tid & 63, r32 = lane & 31, hi = lane >> 5;
  char* V_lds = lds; char* K_lds = lds + 2 * SHM_V;
  float* ws = (float*)(lds + 2 * SHM_V + 2 * SHM_K) + wid * 64; float* li_l = ws; float* al_l = ws + 32;
  char* Qs = lds + 2 * SHM_V + 2 * SHM_K + 2048 + wid * ((ND - NDR) * 1024) + lane * 16;
  float m_reg = -1e30f, l_reg = 0; f32x16 o[4] = {}; bf16x8 qr[NDR];
  const bf16* Qw = Qb + (long)(wid * QBLK + r32) * LDQ + hi * 8;
#pragma unroll
  for (int d0 = 0; d0 < NDR; ++d0) qr[d0] = *reinterpret_cast<const bf16x8*>(Qw + d0 * 16);
#pragma unroll
  for (int d0 = NDR; d0 < ND; ++d0) *(bf16x8*)(Qs + (d0 - NDR) * 1024) = *reinterpret_cast<const bf16x8*>(Qw + d0 * 16);
  const int sr = tid >> 4, sc = (tid & 15) * 8, vst0 = v_st(sr, sc), vst1 = v_st(32 + sr, sc);
  unsigned koff[KCH]; int kdst[KCH]; const unsigned voff0 = (unsigned)(sr * LDK + sc) * 2u, voff1 = (unsigned)((32 + sr) * LDK + sc) * 2u;
#pragma unroll
  for (int i = 0; i < KCH; ++i) { const int c = tid + 512 * i, kr = c / NKC, kc = c % NKC; koff[i] = (unsigned)(kr * LDK + kc * 8) * 2u; kdst[i] = kswz<DQK>(kr, kc * 16); }
  const int vb0 = (int)(uintptr_t)V_lds + v_rd_base(lane);
  bf16x8 vs0, vs1, ks[KCH];
#define SLOAD(k0) do { const char* Kt_ = (const char*)Kh + (size_t)(k0) * (LDK * 2); const char* Vt_ = (const char*)Vh + (size_t)(k0) * (LDK * 2); \
    vs0 = *reinterpret_cast<const bf16x8*>(Vt_ + voff0); vs1 = *reinterpret_cast<const bf16x8*>(Vt_ + voff1); \
    _Pragma("unroll") for (int q_ = 0; q_ < KCH; ++q_) ks[q_] = *reinterpret_cast<const bf16x8*>(Kt_ + koff[q_]); } while (0)
#define SWRITE(b) do { *(bf16x8*)(V_lds + (b) * SHM_V + vst0) = vs0; *(bf16x8*)(V_lds + (b) * SHM_V + vst1) = vs1; \
    _Pragma("unroll") for (int q_ = 0; q_ < KCH; ++q_) *(bf16x8*)(K_lds + (b) * SHM_K + kdst[q_]) = ks[q_]; } while (0)
#define QKT(P0, P1, Ks_) do { const char* Ksb = (Ks_); P0 = f32x16{}; P1 = f32x16{}; \
    _Pragma("unroll") for (int d0 = 0; d0 < ND; ++d0) { const int cb = (d0 * 16 + hi * 8) * 2; \
      const bf16x8 b0 = *reinterpret_cast<const bf16x8*>(Ksb + kswz<DQK>(r32, cb)), b1 = *reinterpret_cast<const bf16x8*>(Ksb + kswz<DQK>(32 + r32, cb)); \
      bf16x8 qf; if (d0 < NDR) qf = qr[d0 < NDR ? d0 : 0]; else qf = *(const bf16x8*)(Qs + (d0 - NDR) * 1024); \
      P0 = __builtin_amdgcn_mfma_f32_32x32x16_bf16(b0, qf, P0, 0, 0, 0); P1 = __builtin_amdgcn_mfma_f32_32x32x16_bf16(b1, qf, P1, 0, 0, 0); } } while (0)
#define RESC(a) do { if (__any((a) < 1.f)) { if (hi == 0) al_l[r32] = (a); asm volatile("s_waitcnt lgkmcnt(0)" ::: "memory"); \
    _Pragma("unroll") for (int d = 0; d < 4; ++d) _Pragma("unroll") for (int r = 0; r < 16; ++r) o[d][r] *= al_l[crow(r, hi)]; } } while (0)
  f32x16 pA0, pA1, pB0, pB1; float mnA, mnB, alA, alB; bf16x8 pa0, pa1, pa2, pa3; const int NT = seq / KVBLK, n = t_end - t_begin;
  const int qrel = wid * QBLK + r32;
#define CMASK(P0, P1, t) do { if constexpr (CAUSAL) { const int jb_ = (t) - (NT - 4); if (jb_ >= 0) cmask(P0, P1, jb_, qrel, hi); } } while (0)
  SLOAD(t_begin * KVBLK); asm volatile("s_waitcnt vmcnt(0)" ::: "memory"); SWRITE(0); __syncthreads();
  QKT(pA0, pA1, K_lds); CMASK(pA0, pA1, t_begin); partialSM<SC>(pA0, pA1, m_reg, mnA, alA);
  SLOAD((t_begin + 1) * KVBLK);
  asm volatile("s_waitcnt vmcnt(0)" ::: "memory"); SWRITE(1); __syncthreads();
  for (int j = 1; j + 1 < n; j += 2) {
    SBAR(); QKT(pB0, pB1, K_lds + SHM_K); CMASK(pB0, pB1, t_begin + j);
    finishSM(pA0, pA1, alA, l_reg, pa0, pa1, pa2, pa3); SBAR();
    SLOAD((t_begin + j + 1) * KVBLK); SBAR();
    pv_d0(o, vb0, pa0, pa1, pa2, pa3); partialSM<SC>(pB0, pB1, m_reg, mnB, alB);
    __syncthreads(); asm volatile("s_waitcnt vmcnt(0)" ::: "memory"); SWRITE(0);
    RESC(alB); __syncthreads();
    SBAR(); QKT(pA0, pA1, K_lds); CMASK(pA0, pA1, t_begin + j + 1);
    finishSM(pB0, pB1, alB, l_reg, pa0, pa1, pa2, pa3); SBAR();
    SLOAD((t_begin + j + 2) * KVBLK); SBAR();
    pv_d0(o, vb0 + SHM_V, pa0, pa1, pa2, pa3); partialSM<SC>(pA0, pA1, m_reg, mnA, alA);
    __syncthreads(); asm volatile("s_waitcnt vmcnt(0)" ::: "memory"); SWRITE(1);
    RESC(alA); __syncthreads();
  }
  SBAR(); QKT(pB0, pB1, K_lds + SHM_K); CMASK(pB0, pB1, t_end - 1);
  finishSM(pA0, pA1, alA, l_reg, pa0, pa1, pa2, pa3); SBAR();
  pv_d0(o, vb0, pa0, pa1, pa2, pa3); partialSM<SC>(pB0, pB1, m_reg, mnB, alB);
  __syncthreads(); RESC(alB);
  finishSM(pB0, pB1, alB, l_reg, pa0, pa1, pa2, pa3); SBAR();
  pv_d0(o, vb0 + SHM_V, pa0, pa1, pa2, pa3);
  if (hi == 0) { li_l[r32] = l_reg; ml[(long)(wid * QBLK + r32) * ml_stride] = m_reg; ml[(long)(wid * QBLK + r32) * ml_stride + 1] = l_reg; }
  asm volatile("s_waitcnt lgkmcnt(0)" ::: "memory");
  float rli[16];
#pragma unroll
  for (int r = 0; r < 16; ++r) { const float lv = li_l[crow(r, hi)]; rli[r] = lv > 0.f ? __builtin_amdgcn_rcpf(lv) : 0.f; }
  bf16* Ow = Ob + (long)(wid * QBLK) * ldo;
#pragma unroll
  for (int r = 0; r < 16; ++r) { const int orow = crow(r, hi);
#pragma unroll
    for (int d0 = 0; d0 < 4; ++d0) Ow[(long)orow * ldo + d0 * 32 + r32] = (bf16)(cvtpk(o[d0][r] * rli[r], 0.f) & 0xffffu); }
  __syncthreads();
#undef SLOAD
#undef SWRITE
#undef QKT
#undef RESC
#undef CMASK
}
}

#define GAS __attribute__((address_space(1)))
#define LAS __attribute__((address_space(3)))
typedef unsigned short bf16;
typedef unsigned v4u __attribute__((ext_vector_type(4)));
typedef float f32x4 __attribute__((ext_vector_type(4)));
typedef short bf16x8 __attribute__((ext_vector_type(8)));
typedef GAS unsigned gu32;
typedef GAS unsigned long long gu64;
#define RLX_AGENT __ATOMIC_RELAXED, __HIP_MEMORY_SCOPE_AGENT
#define LDS_WAIT() asm volatile("s_waitcnt lgkmcnt(0)" ::: "memory")
#define VM_WAIT() asm volatile("s_waitcnt vmcnt(0)" ::: "memory")
__device__ __forceinline__ unsigned long long rt() { return __builtin_amdgcn_s_memrealtime(); }
__device__ __forceinline__ unsigned f2bf(float f) { unsigned u = __builtin_bit_cast(unsigned, f); return (u + 0x7fffu + ((u >> 16) & 1u)) >> 16; }
__device__ __forceinline__ unsigned pk2(float lo, float hi) { return f2bf(lo) | (f2bf(hi) << 16); }

#define XB_TMO      128
#define XB_XCNT(j)  (256  + 64 * (j))
#define XB_XSUB(j)  (1280 + 64 * (j))
#define XB_XGEN(j)  (2304 + 64 * (j))
#define XB_TOP      3328
#define XB_TOPGEN   3392
#define XCD_BAR_WORDS 3456
#define XB_SPIN_CAP (1u << 18)

__device__ __forceinline__ unsigned xb_ld(unsigned* p)              { return __hip_atomic_load(p, __ATOMIC_RELAXED, __HIP_MEMORY_SCOPE_AGENT); }
__device__ __forceinline__ unsigned xb_add(unsigned* p, unsigned v) { return __hip_atomic_fetch_add(p, v, __ATOMIC_RELAXED, __HIP_MEMORY_SCOPE_AGENT); }
__device__ __forceinline__ unsigned xb_xcc_id() { return (unsigned)__builtin_amdgcn_s_getreg((3 << 11) | 20) & 0xFu; }
#define XB_SPIN(cond, bar) do { unsigned _sp = 0; while (cond) { __builtin_amdgcn_s_sleep(1); \
    if ((++_sp & 255u) == 0u) { if (xb_ld(&(bar)[XB_TMO])) break; if (_sp > XB_SPIN_CAP) { atomicAdd(&(bar)[XB_TMO], 1u); break; } } } } while (0)

struct XcdBarrier {
    unsigned* bar; unsigned x;
    volatile LAS unsigned* st;
};

__device__ __forceinline__ XcdBarrier xcd_barrier_post(unsigned* bar, volatile LAS unsigned* st, const int wave_) {
    XcdBarrier b; b.bar = bar; b.x = xb_xcc_id(); b.st = st;
    if (wave_ == 0 && lane_id() == 0) (void)xb_add(&bar[XB_XCNT(b.x)], 1u);
    return b;
}
__device__ __forceinline__ void xcd_barrier_complete(unsigned* bar, unsigned x, unsigned& nloc, unsigned& nx) {
    const unsigned G = gridDim.x * gridDim.y * gridDim.z;
    unsigned sum, cnt, mine, sp = 0u;
    for (;;) {
        sum = 0u; cnt = 0u; mine = 0u;
#pragma unroll
        for (unsigned j = 0; j < 16; ++j) { const unsigned c = xb_ld(&bar[XB_XCNT(j)]); sum += c; cnt += (c > 0u) ? 1u : 0u; mine = (j == x) ? c : mine; }
        if (sum == G) break;
        __builtin_amdgcn_s_sleep(1);
        if ((++sp & 255u) == 0u) { if (xb_ld(&bar[XB_TMO])) break; if (sp > XB_SPIN_CAP) { atomicAdd(&bar[XB_TMO], 1u); break; } }
    }
    nloc = mine > 0u ? mine : 1u; nx = cnt > 0u ? cnt : 1u;
}

__device__ __forceinline__ void xcd_barrier(const XcdBarrier& b, const int wave_) {
    asm volatile("s_waitcnt vmcnt(0)" ::: "memory");
    __syncthreads();
    if (wave_ == 0 && lane_id() == 0) {
        unsigned* bar = b.bar;
        __builtin_amdgcn_s_waitcnt(0);
        unsigned nloc = b.st[0], nx = b.st[1];
        if (nloc == 0u) { xcd_barrier_complete(bar, b.x, nloc, nx); b.st[0] = nloc; b.st[1] = nx; }
        const unsigned old = xb_add(&bar[XB_XSUB(b.x)], 1u);
        const unsigned gen = old / nloc;
        if (old + 1u == (gen + 1u) * nloc) {
            __builtin_amdgcn_fence(__ATOMIC_RELEASE, "agent");
            asm volatile("s_waitcnt vmcnt(0)" ::: "memory");
            const unsigned og = xb_add(&bar[XB_TOP], 1u);
            const unsigned tg = og / nx;
            if (og + 1u == (tg + 1u) * nx) xb_add(&bar[XB_TOPGEN], 1u);
            else XB_SPIN(xb_ld(&bar[XB_TOPGEN]) == tg, bar);
            __builtin_amdgcn_fence(__ATOMIC_ACQUIRE, "agent");
            xb_add(&bar[XB_XGEN(b.x)], 1u);
            asm volatile("s_waitcnt vmcnt(0)" ::: "memory");
        } else {
            XB_SPIN(xb_ld(&bar[XB_XGEN(b.x)]) == gen, bar);
            __builtin_amdgcn_fence(__ATOMIC_ACQUIRE, "agent");
            asm volatile("s_waitcnt vmcnt(0)" ::: "memory");
        }
    }
    __syncthreads();
}

enum Phase { PH_PREP_FFN1 = 0, PH_FFN1_GU, PH_FFN1_DOWN, PH_WIN, PH_UP, PH_FINAL_QK, PH_FINAL_XK, PH_HG_B, PH_ATTN, PH_COMBINE,
             PH_WOUT, PH_XQ, PH_XATTN, PH_XO, PH_FFN2_GU, PH_FFN2_DOWN, PH_COUNT };
constexpr int FFN2_SPLIT = 3600;
#ifndef MK_CMASK
#define MK_CMASK 0xffffffffu
#endif
constexpr unsigned NOBAR_AFTER = (1u << PH_FINAL_QK) | (1u << PH_FINAL_XK);

struct Frame {
    LAS unsigned char* lds; char* ldsg;
    int wave, vcu, G;
    const float* in[30]; float* out; unsigned char* ws;
};
__device__ __forceinline__ float wave_sum(float v) {
#pragma unroll
    for (int o = 1; o < 64; o <<= 1) v += __shfl_xor(v, o);
    return v;
}
__device__ __forceinline__ float bf2f(bf16 b) { return __uint_as_float((unsigned)b << 16); }

template <int MAP> __device__ __forceinline__ int map_row(int n0) {
    if (MAP == 1) return (n0 >> 7) * 256 + (n0 & 127);
    if (MAP == 2) return (n0 >> 7) * 256 + 128 + (n0 & 127);
    if (MAP == 3) return n0 < 832 ? n0 : n0 + 192;
    if (MAP == 4) { const int h = n0 >> 8, j = n0 & 255; return h * 320 + (j < 128 ? j : j + 64); }
    return n0;
}
template <int MAP, bool NTS = false> __device__ __forceinline__ void tr_item(const float* W, int K, int N, const float* gain, int gainK, bf16* WT, LAS float* scr, int item, int lane) {
    const int nblk = N / 64, kb = item / nblk, nb = item % nblk, k0 = 64 * kb, n0 = 64 * nb, c4 = (lane & 15) * 4, kq = lane >> 4;
    f32x4 v[16];
#pragma unroll
    for (int i = 0; i < 16; ++i) v[i] = __builtin_nontemporal_load((const GAS f32x4*)(W + (size_t)(k0 + 4 * i + kq) * N + n0 + c4));
#pragma unroll
    for (int i = 0; i < 16; ++i) { const int kk = 4 * i + kq; const float g = (gain != nullptr && k0 + kk < gainK) ? gain[k0 + kk] : 1.0f;
        *(LAS f32x4*)(scr + kk * 64 + (c4 ^ (((kk >> 3) & 7) << 2))) = v[i] * g; }
    LDS_WAIT(); asm volatile("" ::: "memory");
    const int c = lane & 7, dr0 = map_row<MAP>(n0);
#pragma unroll
    for (int j = 0; j < 8; ++j) { const int n = (lane >> 3) + 8 * j; const LAS float* s = scr + (8 * c) * 64 + (n ^ (c << 2));
        v4u o; o.x = cvtpk(s[0 * 64], s[1 * 64]); o.y = cvtpk(s[2 * 64], s[3 * 64]); o.z = cvtpk(s[4 * 64], s[5 * 64]); o.w = cvtpk(s[6 * 64], s[7 * 64]);
        if (NTS) __builtin_nontemporal_store(o, (GAS v4u*)(WT + (size_t)(dr0 + n) * K + k0 + 8 * c)); else *(GAS v4u*)(WT + (size_t)(dr0 + n) * K + k0 + 8 * c) = o; }
    LDS_WAIT(); asm volatile("" ::: "memory");
}
__device__ __forceinline__ void norm_row_bf16(const float* xrow, const float* g, bf16* orow, int lane) {
    const GAS f32x4* xr = (const GAS f32x4*)xrow + lane; const GAS f32x4* gr = (const GAS f32x4*)g + lane;
    f32x4 v[8]; float s = 0.f;
#pragma unroll
    for (int j = 0; j < 8; ++j) { v[j] = xr[64 * j]; s += pg8::dot4(v[j]); }
    const float rstd = 1.0f / sqrtf(wave_sum(s) * (1.0f / DM) + EPS);
    GAS unsigned long long* o8 = (GAS unsigned long long*)orow + lane;
#pragma unroll
    for (int j = 0; j < 8; ++j) { const f32x4 gg = gr[64 * j]; o8[64 * j] = (unsigned long long)cvtpk(v[j].x * rstd * gg.x, v[j].y * rstd * gg.y) | ((unsigned long long)cvtpk(v[j].z * rstd * gg.z, v[j].w * rstd * gg.w) << 32); }
}
#define GW_LOOP(var, n) for (int var = gw; var < (n); var += NGW)
constexpr int I_FFN_G = (DM / 64) * (DFF / 64), I_FFN_D = (DFF / 64) * (DM / 64);
__device__ __forceinline__ void ph_prep_ffn1(Frame& F) {
    LAS float* scr = (LAS float*)(F.lds + F.wave * 16384);
    const int gw = F.vcu * NWAVES + F.wave, NGW = F.G * NWAVES;
    bf16* WGU = (bf16*)(F.ws + WS_WGU);
    GW_LOOP(it, 2 * I_FFN_G) { if (it < I_FFN_G) tr_item<1>(F.in[4], DM, DFF, nullptr, 0, WGU, scr, it, lane_id()); else tr_item<2>(F.in[5], DM, DFF, nullptr, 0, WGU, scr, it - I_FFN_G, lane_id()); }
    bf16* XB = (bf16*)(F.ws + WS_XB); GW_LOOP(m, M) norm_row_bf16(F.in[0] + (size_t)m * DM, F.in[3], XB + (size_t)m * DM, lane_id());
}
__device__ __forceinline__ void tail_job_a(Frame& F, int worker, int nworkers) {
    LAS float* scr = (LAS float*)(F.lds + F.wave * 16384);
    const int gw = worker * NWAVES + F.wave, NGW = nworkers * NWAVES;
    bf16* WD = (bf16*)(F.ws + WS_WD); bf16* WIN = (bf16*)(F.ws + WS_WIN); bf16* WQUP = (bf16*)(F.ws + WS_WQUP); bf16* WKVUP = (bf16*)(F.ws + WS_WKVUP); bf16* WOUT = (bf16*)(F.ws + WS_WOUT);
    bf16* WXQ = (bf16*)(F.ws + WS_WXQ); bf16* WXKV = (bf16*)(F.ws + WS_WXKV); bf16* WXO = (bf16*)(F.ws + WS_WXO);
    constexpr int I_IN = (DM / 64) * (INC / 64), I_Q = (512 / 64) * (1536 / 64), I_KV = (256 / 64) * (2048 / 64), I_O = (DM / 64) * (DM / 64);
    constexpr int I_XQ = (DM / 64) * (512 / 64), I_XKV = (DM / 64) * (1024 / 64), I_XO = (512 / 64) * (DM / 64);
    GW_LOOP(it, I_FFN_D + I_IN + I_Q + I_KV + I_O + I_XQ + I_XKV + I_XO) {
        int r = it;
        if (r < I_XQ) { tr_item<0, true>(F.in[21], DM, 512, F.in[19], DM, WXQ, scr, r, lane_id()); continue; } r -= I_XQ;
        if (r < I_XO) { tr_item<0, true>(F.in[25], 512, DM, nullptr, 0, WXO, scr, r, lane_id()); continue; } r -= I_XO;
        if (r < I_O) { tr_item<0>(F.in[18], DM, DM, F.in[15], 1024, WOUT, scr, r, lane_id()); continue; } r -= I_O;
        if (r < I_XKV) { tr_item<0>(F.in[22], DM, 1024, nullptr, 0, WXKV, scr, r, lane_id()); continue; } r -= I_XKV;
        if (r < I_Q) { tr_item<0>(F.in[10], 512, 1536, F.in[9], 512, WQUP, scr, r, lane_id()); continue; } r -= I_Q;
        if (r < I_KV) { tr_item<4>(F.in[12], 256, 2048, F.in[11], 256, WKVUP, scr, r, lane_id()); continue; } r -= I_KV;
        if (r < I_IN) { tr_item<3>(F.in[8], DM, INC, F.in[7], DM, WIN, scr, r, lane_id()); continue; } r -= I_IN;
        tr_item<0>(F.in[6], DFF, DM, nullptr, 0, WD, scr, r, lane_id());
    }
    const int gt = gw * 64 + lane_id(), NGT = NGW * 64;
    for (int i = gt; i < 192 * 256; i += NGT) *(GAS v4u*)(WIN + (size_t)832 * DM + (size_t)i * 8) = (v4u){0u, 0u, 0u, 0u};
    for (int i = gt; i < 8 * 64 * 32; i += NGT) { const int h = i >> 11, rr = (i >> 5) & 63, c = i & 31; *(GAS v4u*)(WKVUP + (size_t)(h * 320 + 128 + rr) * 256 + c * 8) = (v4u){0u, 0u, 0u, 0u}; }
    float* LB = (float*)(F.ws + WS_LB); float* ROPE = (float*)(F.ws + WS_ROPE);
    for (int i = gt; i < 1024; i += NGT) { const float l0 = F.in[16][i], l1 = F.in[16][1024 + i]; const float mx = fmaxf(l0, l1); const float e0 = expf(l0 - mx), e1 = expf(l1 - mx); LB[i] = e0 / (e0 + e1); }
    const int* pos = (const int*)F.in[2];
    for (int i = gt; i < M * 32; i += NGT) { const int row = i >> 5, fq = i & 31; const float inv_freq = powf(10000.0f, -(float)fq / 32.0f); const float ang = (float)pos[row] * inv_freq;
        ROPE[(size_t)row * 64 + fq] = cosf(ang); ROPE[(size_t)row * 64 + 32 + fq] = sinf(ang); }
    bf16* MEMN = (bf16*)(F.ws + WS_MEMN);
    GW_LOOP(m, MMEM) norm_row_bf16(F.in[1] + (size_t)m * DM, F.in[20], MEMN + (size_t)m * DM, lane_id());
}
__device__ __forceinline__ void tail_job_ffn2(Frame& F, int worker, int nworkers, int lo, int hi) {
    LAS float* scr = (LAS float*)(F.lds + F.wave * 16384);
    const int gw = worker * NWAVES + F.wave, NGW = nworkers * NWAVES;
    bf16* WGU = (bf16*)(F.ws + WS_W2GU); bf16* WD = (bf16*)(F.ws + WS_W2D);
    for (int it = lo + gw; it < hi; it += NGW) {
        if (it < I_FFN_G) tr_item<1, true>(F.in[27], DM, DFF, F.in[26], DM, WGU, scr, it, lane_id());
        else if (it < 2 * I_FFN_G) tr_item<2, true>(F.in[28], DM, DFF, F.in[26], DM, WGU, scr, it - I_FFN_G, lane_id());
        else tr_item<0, true>(F.in[29], DFF, DM, nullptr, 0, WD, scr, it - 2 * I_FFN_G, lane_id());
    }
}
__device__ __forceinline__ bool light_worker(int nwg, int G, int c, int& worker, int& nworkers) {
    const int rounds = (nwg + G - 1) / G, rem = nwg - (rounds - 1) * G;
    if (rem >= G) { worker = c; nworkers = G; return true; }
    worker = c - rem; nworkers = G - rem; return c >= rem;
}

__device__ __forceinline__ void ph_final_qk(Frame& F) {
    const int gw = F.vcu * NWAVES + F.wave, NGW = F.G * NWAVES, lane = lane_id(), h = lane >> 3, s = lane & 7;
    bf16* QRAW = (bf16*)(F.ws + WS_QRAW); bf16* KV = (bf16*)(F.ws + WS_KV); const float* KPE = (const float*)(F.ws + WS_KPE); const float* ROPE = (const float*)(F.ws + WS_ROPE);
    const float* qn = F.in[13]; const float* kn = F.in[14];
    f32x4 gq[6], gk[6];
#pragma unroll
    for (int j = 0; j < 3; ++j) { gq[2 * j] = *(const f32x4*)(qn + 64 * j + 8 * s); gq[2 * j + 1] = *(const f32x4*)(qn + 64 * j + 8 * s + 4);
                                  gk[2 * j] = *(const f32x4*)(kn + 64 * j + 8 * s); gk[2 * j + 1] = *(const f32x4*)(kn + 64 * j + 8 * s + 4); }
    const float sgn = (s < 4) ? -1.0f : 1.0f;
    for (int row0 = gw; row0 < M; row0 += 2 * NGW) {
        v4u qw[2][3], kw[2][2]; f32x4 kp0[2], kp1[2], c0[2], c1[2], s0[2], s1[2]; int rowv[2]; bool ok[2];
#pragma unroll
        for (int q = 0; q < 2; ++q) { const int row = row0 + q * NGW; ok[q] = row < M; rowv[q] = ok[q] ? row : row0;
            const bf16* qp = QRAW + (size_t)rowv[q] * 1536 + h * 192 + 8 * s; const bf16* kp = KV + (size_t)rowv[q] * KVP + h * 320 + 8 * s;
#pragma unroll
            for (int j = 0; j < 3; ++j) qw[q][j] = *(const v4u*)(qp + 64 * j);
#pragma unroll
            for (int j = 0; j < 2; ++j) kw[q][j] = *(const v4u*)(kp + 64 * j);
            kp0[q] = *(const f32x4*)(KPE + (size_t)rowv[q] * 64 + 8 * s); kp1[q] = *(const f32x4*)(KPE + (size_t)rowv[q] * 64 + 8 * s + 4);
            c0[q] = *(const f32x4*)(ROPE + (size_t)rowv[q] * 64 + 8 * (s & 3)); c1[q] = *(const f32x4*)(ROPE + (size_t)rowv[q] * 64 + 8 * (s & 3) + 4);
            s0[q] = *(const f32x4*)(ROPE + (size_t)rowv[q] * 64 + 32 + 8 * (s & 3)); s1[q] = *(const f32x4*)(ROPE + (size_t)rowv[q] * 64 + 32 + 8 * (s & 3) + 4); }
#pragma unroll
        for (int q = 0; q < 2; ++q) {
            {
                float v[3][8]; float ss = 0.f;
#pragma unroll
                for (int j = 0; j < 3; ++j)
#pragma unroll
                    for (int e = 0; e < 4; ++e) { v[j][2 * e] = bflo(qw[q][j][e]); v[j][2 * e + 1] = bfhi(qw[q][j][e]); ss += v[j][2 * e] * v[j][2 * e] + v[j][2 * e + 1] * v[j][2 * e + 1]; }
                ss += __shfl_xor(ss, 1); ss += __shfl_xor(ss, 2); ss += __shfl_xor(ss, 4);
                const float rstd = 1.0f / sqrtf(ss * (1.0f / 192.0f) + EPS);
#pragma unroll
                for (int j = 0; j < 3; ++j)
#pragma unroll
                    for (int e = 0; e < 8; ++e) v[j][e] *= rstd * ((e < 4) ? gq[2 * j][e & 3] : gq[2 * j + 1][e & 3]);
#pragma unroll
                for (int e = 0; e < 8; ++e) { const float other = __shfl_xor(v[2][e], 4); const float c = (e < 4) ? c0[q][e & 3] : c1[q][e & 3], sn = (e < 4) ? s0[q][e & 3] : s1[q][e & 3]; v[2][e] = v[2][e] * c + sgn * other * sn; }
                if (ok[q]) { bf16* qp = QRAW + (size_t)rowv[q] * 1536 + h * 192 + 8 * s;
#pragma unroll
                    for (int j = 0; j < 3; ++j) { v4u o; o.x = cvtpk(v[j][0], v[j][1]); o.y = cvtpk(v[j][2], v[j][3]); o.z = cvtpk(v[j][4], v[j][5]); o.w = cvtpk(v[j][6], v[j][7]); *(v4u*)(qp + 64 * j) = o; } }
            }
            {
                float v[3][8]; float ss = 0.f;
#pragma unroll
                for (int j = 0; j < 2; ++j)
#pragma unroll
                    for (int e = 0; e < 4; ++e) { v[j][2 * e] = bflo(kw[q][j][e]); v[j][2 * e + 1] = bfhi(kw[q][j][e]); ss += v[j][2 * e] * v[j][2 * e] + v[j][2 * e + 1] * v[j][2 * e + 1]; }
#pragma unroll
                for (int e = 0; e < 4; ++e) { v[2][e] = kp0[q][e]; v[2][4 + e] = kp1[q][e]; }
                ss += pg8::dot4(kp0[q]) + pg8::dot4(kp1[q]);
                ss += __shfl_xor(ss, 1); ss += __shfl_xor(ss, 2); ss += __shfl_xor(ss, 4);
                const float rstd = 1.0f / sqrtf(ss * (1.0f / 192.0f) + EPS);
#pragma unroll
                for (int j = 0; j < 3; ++j)
#pragma unroll
                    for (int e = 0; e < 8; ++e) v[j][e] *= rstd * ((e < 4) ? gk[2 * j][e & 3] : gk[2 * j + 1][e & 3]);
#pragma unroll
                for (int e = 0; e < 8; ++e) { const float other = __shfl_xor(v[2][e], 4); const float c = (e < 4) ? c0[q][e & 3] : c1[q][e & 3], sn = (e < 4) ? s0[q][e & 3] : s1[q][e & 3]; v[2][e] = v[2][e] * c + sgn * other * sn; }
                if (ok[q]) { bf16* kp = KV + (size_t)rowv[q] * KVP + h * 320 + 8 * s;
#pragma unroll
                    for (int j = 0; j < 3; ++j) { v4u o; o.x = cvtpk(v[j][0], v[j][1]); o.y = cvtpk(v[j][2], v[j][3]); o.z = cvtpk(v[j][4], v[j][5]); o.w = cvtpk(v[j][6], v[j][7]); *(v4u*)(kp + 64 * j) = o; } }
            }
        }
    }
}
__device__ __forceinline__ void ph_final_xk(Frame& F) {
    const int gw = F.vcu * NWAVES + F.wave, NGW = F.G * NWAVES, lane = lane_id(), h = lane >> 4, s = lane & 15;
    bf16* XKV = (bf16*)(F.ws + WS_XKV); const float* g = F.in[24];
    const f32x4 g0 = *(const f32x4*)(g + 8 * s), g1 = *(const f32x4*)(g + 8 * s + 4);
    GW_LOOP(row, MMEM) {
        bf16* kp = XKV + (size_t)row * 1024 + h * 256 + 8 * s;
        const v4u w = *(const v4u*)kp; float v[8]; float ss = 0.f;
#pragma unroll
        for (int e = 0; e < 4; ++e) { v[2 * e] = bflo(w[e]); v[2 * e + 1] = bfhi(w[e]); ss += v[2 * e] * v[2 * e] + v[2 * e + 1] * v[2 * e + 1]; }
        ss += __shfl_xor(ss, 1); ss += __shfl_xor(ss, 2); ss += __shfl_xor(ss, 4); ss += __shfl_xor(ss, 8);
        const float rstd = 1.0f / sqrtf(ss * (1.0f / 128.0f) + EPS);
        v4u o; o.x = cvtpk(v[0] * rstd * g0[0], v[1] * rstd * g0[1]); o.y = cvtpk(v[2] * rstd * g0[2], v[3] * rstd * g0[3]);
        o.z = cvtpk(v[4] * rstd * g1[0], v[5] * rstd * g1[1]); o.w = cvtpk(v[6] * rstd * g1[2], v[7] * rstd * g1[3]);
        *(v4u*)kp = o;
    }
}

typedef float f32x2 __attribute__((ext_vector_type(2)));
struct HgaIn { f32x2 lf[8]; unsigned hq[8]; bf16x8 v0, v1; };
__device__ __forceinline__ void hg_a_load(Frame& F, int item, HgaIn& in, int tid) {
    const int bh = item >> 5, c = item & 31, b = bh >> 3, h = bh & 7, seg = tid >> 6, k2 = tid & 63;
    const size_t row0 = (size_t)b * SEQ + (size_t)c * 64; const int hcol = h * 128;
    const bf16* HQ = (const bf16*)(F.ws + WS_HQ); const float* LF = (const float*)(F.ws + WS_LF); const bf16* HI = (const bf16*)(F.ws + WS_HI);
#pragma unroll
    for (int i = 0; i < 8; ++i) { const size_t e = (row0 + seg * 8 + i) * 1024 + hcol + 2 * k2; in.lf[i] = __builtin_nontemporal_load((const f32x2*)(LF + e)); in.hq[i] = __builtin_nontemporal_load((const unsigned*)(HQ + e)); }
    const int sr = tid >> 4, sc = (tid & 15) * 8;
    in.v0 = __builtin_nontemporal_load((const bf16x8*)(HI + (row0 + sr) * 1024 + hcol + sc)); in.v1 = __builtin_nontemporal_load((const bf16x8*)(HI + (row0 + 32 + sr) * 1024 + hcol + sc));
}
__device__ __forceinline__ void ph_hg_a(Frame& F) {
    using namespace att;
    int tid = (F.wave * 64 + lane_id()); asm volatile("" : "+v"(tid));
    const int lane = tid & 63, wid = F.wave, r32 = lane & 31, hi = lane >> 5;
    bf16* OINTRA = (bf16*)F.out; bf16* QT = (bf16*)F.out + (size_t)M * 1024;
    bf16* DSB = (bf16*)(F.ws + WS_DS); float* DV = (float*)(F.ws + WS_DV);
    char* QtL = F.ldsg; char* KtL = F.ldsg + 16384; char* VL = F.ldsg + 32768; char* KdT = F.ldsg + 49152; float* tot = (float*)(F.ldsg + 49152 + 18432);
    int item = F.vcu; if (item >= 1024) return;
    HgaIn in; hg_a_load(F, item, in, tid);
    for (; item < 1024; item += F.G) {
        const int bh = item >> 5, c = item & 31, b = bh >> 3, h = bh & 7;
        const size_t row0 = (size_t)b * SEQ + (size_t)c * 64; const int hcol = h * 128;
        {
            const int seg = tid >> 6, k2 = tid & 63;
            f32x2 cs[8]; f32x2 run = {0.f, 0.f};
#pragma unroll
            for (int i = 0; i < 8; ++i) { run += in.lf[i]; cs[i] = run; }
            *(f32x2*)(tot + seg * 128 + 2 * k2) = run;
            __syncthreads();
            f32x2 pre = {0.f, 0.f}, blast = {0.f, 0.f};
#pragma unroll
            for (int s2 = 0; s2 < 8; ++s2) { const f32x2 tv = *(const f32x2*)(tot + s2 * 128 + 2 * k2); if (s2 < seg) pre += tv; blast += tv; }
            float kd[2][8];
#pragma unroll
            for (int i = 0; i < 8; ++i) { const int t = seg * 8 + i; float qt[2], kt[2];
#pragma unroll
                for (int e = 0; e < 2; ++e) { const float bb = pre[e] + cs[i][e]; const float fv = __expf(in.lf[i][e]); const float kk = 1.0f - fv; const float qv = e ? bfhi(in.hq[i]) : bflo(in.hq[i]);
                    qt[e] = qv * __expf(bb); kt[e] = kk * __expf(-bb); kd[e][i] = kk * __expf(blast[e] - bb); }
                const unsigned qw = cvtpk(qt[0], qt[1]);
                *(unsigned*)(QT + (row0 + t) * 1024 + hcol + 2 * k2) = qw;
                *(unsigned*)(QtL + kswz<128>(t, 4 * k2)) = qw; *(unsigned*)(KtL + kswz<128>(t, 4 * k2)) = cvtpk(kt[0], kt[1]); }
#pragma unroll
            for (int e = 0; e < 2; ++e) *(v4u*)(KdT + (2 * k2 + e) * 144 + seg * 16) = (v4u){cvtpk(kd[e][0], kd[e][1]), cvtpk(kd[e][2], kd[e][3]), cvtpk(kd[e][4], kd[e][5]), cvtpk(kd[e][6], kd[e][7])};
            if (seg == 0) *(f32x2*)(DV + (size_t)item * 128 + 2 * k2) = (f32x2){__expf(blast[0]), __expf(blast[1])};
            const int sr = tid >> 4, sc = (tid & 15) * 8;
            *(bf16x8*)(VL + v_st(sr, sc)) = in.v0; *(bf16x8*)(VL + v_st(32 + sr, sc)) = in.v1;
        }
        __syncthreads();
        if (item + F.G < 1024) hg_a_load(F, item + F.G, in, tid);
        const int vb = (int)(uintptr_t)VL + v_rd_base(lane);
        {
            const int rh = wid & 1, dq = wid >> 1;
            bf16x8 qr[8];
#pragma unroll
            for (int d0 = 0; d0 < 8; ++d0) qr[d0] = *(const bf16x8*)(QtL + kswz<128>(32 * rh + r32, (16 * d0 + 8 * hi) * 2));
            f32x16 p0, p1; qkt<128>(p0, p1, KtL, qr, r32, hi);
            const int tt = 32 * rh + r32;
#pragma unroll
            for (int r = 0; r < 16; ++r) { const int sk = crow(r, hi); if (sk > tt) p0[r] = 0.f; if (sk + 32 > tt) p1[r] = 0.f; }
            bf16x8 pa0, pa1, pa2, pa3; pack_p(p0, p1, pa0, pa1, pa2, pa3);
            f32x16 od = {}; pv_one<0>(od, vb + dq * 512, pa0, pa1, pa2, pa3);
#pragma unroll
            for (int r = 0; r < 16; ++r) OINTRA[(row0 + 32 * rh + crow(r, hi)) * 1024 + hcol + 32 * dq + r32] = (bf16)(cvtpk(od[r], 0.f) & 0xffffu);
        }
        {
            const int d0 = wid & 3, kh = wid >> 2, vbb = vb + d0 * 512;
            const s16x4 l0 = tr_read<v_rd_off(0, 0, 0)>(vbb), h0 = tr_read<v_rd_off(0, 0, 1)>(vbb), l1 = tr_read<v_rd_off(0, 1, 0)>(vbb), h1 = tr_read<v_rd_off(0, 1, 1)>(vbb);
            const s16x4 l2 = tr_read<v_rd_off(0, 2, 0)>(vbb), h2 = tr_read<v_rd_off(0, 2, 1)>(vbb), l3 = tr_read<v_rd_off(0, 3, 0)>(vbb), h3 = tr_read<v_rd_off(0, 3, 1)>(vbb);
            asm volatile("s_waitcnt lgkmcnt(0)" ::: "memory"); SBAR();
#pragma unroll
            for (int kb = 0; kb < 2; ++kb) {
                const int kcol = 64 * kh + 32 * kb + r32; const char* kp = KdT + kcol * 144 + hi * 16;
                f32x16 acc = {};
                acc = __builtin_amdgcn_mfma_f32_32x32x16_bf16(ATT_PK(l0, h0), *(const bf16x8*)(kp), acc, 0, 0, 0);
                acc = __builtin_amdgcn_mfma_f32_32x32x16_bf16(ATT_PK(l1, h1), *(const bf16x8*)(kp + 32), acc, 0, 0, 0);
                acc = __builtin_amdgcn_mfma_f32_32x32x16_bf16(ATT_PK(l2, h2), *(const bf16x8*)(kp + 64), acc, 0, 0, 0);
                acc = __builtin_amdgcn_mfma_f32_32x32x16_bf16(ATT_PK(l3, h3), *(const bf16x8*)(kp + 96), acc, 0, 0, 0);
#pragma unroll
                for (int r = 0; r < 16; ++r) DSB[(size_t)item * 16384 + (size_t)(32 * d0 + crow(r, hi)) * 128 + 64 * kh + 32 * kb + r32] = (bf16)(cvtpk(acc[r], 0.f) & 0xffffu);
            }
        }
        __syncthreads();
    }
}
__device__ __forceinline__ void ph_hg_b(Frame& F) {
    const bf16* DSB = (const bf16*)(F.ws + WS_DS); const float* DV = (const float*)(F.ws + WS_DV); bf16* STB = (bf16*)(F.ws + WS_LF);
    for (int idx = F.vcu * 512 + (F.wave * 64 + lane_id()); idx < 32 * 4096; idx += F.G * 512) {
        const int bh = idx >> 12, e = idx & 4095, v = e >> 5, k4 = (e & 31) * 4;
        f32x4 st = {0.f, 0.f, 0.f, 0.f};
        for (int c0 = 0; c0 < 32; c0 += 8) {
            f32x4 ds[8], dd[8];
#pragma unroll
            for (int j = 0; j < 8; ++j) { const size_t item = (size_t)bh * 32 + c0 + j; const unsigned long long w = __builtin_nontemporal_load((const unsigned long long*)(DSB + item * 16384 + v * 128 + k4));
                ds[j] = (f32x4){bflo((unsigned)w), bfhi((unsigned)w), bflo((unsigned)(w >> 32)), bfhi((unsigned)(w >> 32))}; dd[j] = *(const f32x4*)(DV + item * 128 + k4); }
#pragma unroll
            for (int j = 0; j < 8; ++j) { const size_t item = (size_t)bh * 32 + c0 + j;
                *(unsigned long long*)(STB + item * 16384 + v * 128 + k4) = (unsigned long long)cvtpk(st[0], st[1]) | ((unsigned long long)cvtpk(st[2], st[3]) << 32);
                st = dd[j] * st + ds[j]; }
        }
    }
}
__device__ __forceinline__ void hg_c_unit(Frame& F, int unit) {
    using namespace att;
    const int bh = unit >> 3, c4 = unit & 7, b = bh >> 3, h = bh & 7, lane = lane_id(), wid = F.wave, r32 = lane & 31, hi = lane >> 5, tid = (F.wave * 64 + lane_id());
    const int ci = wid >> 1, c = c4 * 4 + ci, rh = wid & 1, hcol = h * 128;
    const size_t row_t = (size_t)b * SEQ + (size_t)c * 64 + 32 * rh + r32;
    const bf16* QT = (const bf16*)F.out + (size_t)M * 1024; const bf16* STB = (const bf16*)(F.ws + WS_LF); const bf16* OINTRA = (const bf16*)F.out;
    const bf16* HG = (const bf16*)(F.ws + WS_HG); bf16* MIX = (bf16*)(F.ws + WS_MIX); const float* gn = F.in[17];
    { const bf16* src = STB + ((size_t)bh * 32 + c4 * 4) * 16384; v4u t[16];
#pragma unroll
      for (int i = 0; i < 16; ++i) t[i] = *(const v4u*)(src + (size_t)(tid + 512 * i) * 8);
#pragma unroll
      for (int i = 0; i < 16; ++i) { const int cidx = tid + 512 * i, cj = cidx >> 11, wi = cidx & 2047, v = wi >> 4, cc = wi & 15; *(v4u*)(F.ldsg + cj * 32768 + kswz<128>(v, cc * 16)) = t[i]; } }
    bf16x8 qf[8];
#pragma unroll
    for (int ks = 0; ks < 8; ++ks) qf[ks] = *(const bf16x8*)(QT + row_t * 1024 + hcol + 16 * ks + 8 * hi);
    __syncthreads();
    const char* Sl = F.ldsg + ci * 32768;
    f32x16 acc[4];
#pragma unroll
    for (int d0 = 0; d0 < 4; ++d0) { acc[d0] = f32x16{};
#pragma unroll
        for (int ks = 0; ks < 8; ++ks) acc[d0] = __builtin_amdgcn_mfma_f32_32x32x16_bf16(*(const bf16x8*)(Sl + kswz<128>(32 * d0 + r32, (16 * ks + 8 * hi) * 2)), qf[ks], acc[d0], 0, 0, 0); }
    float ss = 0.f;
#pragma unroll
    for (int d0 = 0; d0 < 4; ++d0)
#pragma unroll
        for (int g = 0; g < 4; ++g) { const unsigned long long ow = *(const unsigned long long*)(OINTRA + row_t * 1024 + hcol + 32 * d0 + 8 * g + 4 * hi);
            const f32x4 oi = {bflo((unsigned)ow), bfhi((unsigned)ow), bflo((unsigned)(ow >> 32)), bfhi((unsigned)(ow >> 32))};
#pragma unroll
            for (int i = 0; i < 4; ++i) { acc[d0][4 * g + i] += oi[i]; ss += acc[d0][4 * g + i] * acc[d0][4 * g + i]; } }
    ss += __shfl_xor(ss, 32);
    const float rstd = 1.0f / sqrtf(ss * (1.0f / 128.0f) + EPS);
#pragma unroll
    for (int d0 = 0; d0 < 4; ++d0)
#pragma unroll
        for (int g = 0; g < 4; ++g) { const int vc = 32 * d0 + 8 * g + 4 * hi;
            const unsigned long long gw2 = *(const unsigned long long*)(HG + row_t * 1024 + hcol + vc); const f32x4 gg = *(const f32x4*)(gn + vc);
            const float g0 = bflo((unsigned)gw2), g1 = bfhi((unsigned)gw2), g2 = bflo((unsigned)(gw2 >> 32)), g3 = bfhi((unsigned)(gw2 >> 32));
            const float o0 = acc[d0][4 * g + 0] * rstd * gg[0] * g0 * pg8::fsigmoid(g0), o1 = acc[d0][4 * g + 1] * rstd * gg[1] * g1 * pg8::fsigmoid(g1);
            const float o2 = acc[d0][4 * g + 2] * rstd * gg[2] * g2 * pg8::fsigmoid(g2), o3 = acc[d0][4 * g + 3] * rstd * gg[3] * g3 * pg8::fsigmoid(g3);
            *(unsigned long long*)(MIX + row_t * 2048 + 1024 + hcol + vc) = (unsigned long long)cvtpk(o0, o1) | ((unsigned long long)cvtpk(o2, o3) << 32); }
    __syncthreads();
}

__device__ __forceinline__ void ph_combine(Frame& F) {
    const int gw = F.vcu * NWAVES + F.wave, NGW = F.G * NWAVES, lane = lane_id(), h = lane >> 3;
    bf16* MIX = (bf16*)(F.ws + WS_MIX); const bf16* P1 = (const bf16*)F.out + (size_t)M * 2048; const float* ML = (const float*)(F.ws + WS_KPE);
    float* RSO = (float*)(F.ws + WS_CTL) + CW_RS + RS_O * M;
    constexpr float C = att::ScaleMLA::S * 1.4426950408889634f;
    for (int row0 = gw; row0 < M; row0 += 2 * NGW) {
        v4u a0[2], a1[2], b0[2], b1[2]; float m0[2], l0[2], m1[2], l1[2]; int rowv[2]; bool ok[2];
#pragma unroll
        for (int q = 0; q < 2; ++q) { const int row = row0 + q * NGW; ok[q] = row < M; rowv[q] = ok[q] ? row : row0;
            a0[q] = __builtin_nontemporal_load((const v4u*)(MIX + (size_t)rowv[q] * 2048 + lane * 16)); a1[q] = __builtin_nontemporal_load((const v4u*)(MIX + (size_t)rowv[q] * 2048 + lane * 16 + 8));
            b0[q] = __builtin_nontemporal_load((const v4u*)(P1 + (size_t)rowv[q] * 1024 + lane * 16)); b1[q] = __builtin_nontemporal_load((const v4u*)(P1 + (size_t)rowv[q] * 1024 + lane * 16 + 8));
            m0[q] = ML[((size_t)rowv[q] * 8 + h) * 2]; l0[q] = ML[((size_t)rowv[q] * 8 + h) * 2 + 1]; m1[q] = ML[(((size_t)M + rowv[q]) * 8 + h) * 2]; l1[q] = ML[(((size_t)M + rowv[q]) * 8 + h) * 2 + 1]; }
#pragma unroll
        for (int q = 0; q < 2; ++q) {
            const float mm = fmaxf(m0[q], m1[q]); const float w0 = l0[q] * __builtin_amdgcn_exp2f((m0[q] - mm) * C), w1 = l1[q] * __builtin_amdgcn_exp2f((m1[q] - mm) * C);
            const float inv = 1.0f / (w0 + w1), c0 = w0 * inv, c1 = w1 * inv; float ss = 0.f; v4u o0, o1;
#pragma unroll
            for (int e = 0; e < 4; ++e) { const float x0 = c0 * bflo(a0[q][e]) + c1 * bflo(b0[q][e]), x1 = c0 * bfhi(a0[q][e]) + c1 * bfhi(b0[q][e]), y0 = c0 * bflo(a1[q][e]) + c1 * bflo(b1[q][e]), y1 = c0 * bfhi(a1[q][e]) + c1 * bfhi(b1[q][e]);
                ss += x0 * x0 + x1 * x1 + y0 * y0 + y1 * y1; o0[e] = cvtpk(x0, x1); o1[e] = cvtpk(y0, y1); }
            ss = wave_sum(ss);
            if (ok[q]) { *(v4u*)(MIX + (size_t)rowv[q] * 2048 + lane * 16) = o0; *(v4u*)(MIX + (size_t)rowv[q] * 2048 + lane * 16 + 8) = o1; if (lane == 0) RSO[rowv[q]] = ss; }
        }
    }
}

struct Args { const float* in[30]; float* out; unsigned char* ws; unsigned phmask; unsigned use_bar; };
__global__ void __launch_bounds__(NWAVES * 64, 2) mk_fwd(Args args) {
    extern __shared__ __attribute__((aligned(16))) unsigned char lds[];
    Frame F;
    F.lds = (LAS unsigned char*)lds; F.ldsg = (char*)lds;
    F.wave = __builtin_amdgcn_readfirstlane((int)threadIdx.x >> 6);
    F.G = gridDim.x; { const int bx = blockIdx.x; F.vcu = (F.G % 8 == 0) ? (bx % 8) * (F.G / 8) + bx / 8 : bx; }
#pragma unroll
    for (int i = 0; i < 30; ++i) F.in[i] = args.in[i];
    F.out = args.out; F.ws = args.ws;
    unsigned char* ws = args.ws;
    gu32* ctl = (gu32*)(ws + WS_CTL);
    for (int u = F.wave * 64 + lane_id(); u < (LDS_BYTES - LDSCTL_OFF) / 4; u += NWAVES * 64) ((LAS unsigned*)(F.lds + LDSCTL_OFF))[u] = 0u;
    __syncthreads();
    volatile LAS unsigned* MISC = (volatile LAS unsigned*)(F.lds + MISC_OFF);
#if defined(MK_TS_FROM) && (MK_TS_FROM == -1)
    if (blockIdx.x == 0 && (F.wave * 64 + lane_id()) == 0) { const unsigned long long t_ = __builtin_amdgcn_s_memrealtime(); MISC[16] = (unsigned)t_; MISC[17] = (unsigned)(t_ >> 32); }
#endif
    XcdBarrier bar; bar.bar = (unsigned*)(ctl + CW_BAR); bar.x = 0; bar.st = nullptr;
    if (args.use_bar) bar = xcd_barrier_post((unsigned*)(ctl + CW_BAR), MISC + 8, F.wave);
    float* RS = (float*)(ctl + CW_RS);
    bf16* XB = (bf16*)(ws + WS_XB); bf16* ACT = (bf16*)(ws + WS_ACT); bf16* MIX = (bf16*)(ws + WS_MIX);
    const unsigned phmask = args.phmask;
    bool pending = false;
#ifdef MK_TS_FROM
#define TS_HOOK(p) do { if (blockIdx.x == 0 && (F.wave * 64 + lane_id()) == 0) { if ((p) == MK_TS_FROM) { const unsigned long long t_ = __builtin_amdgcn_s_memrealtime(); MISC[16] = (unsigned)t_; MISC[17] = (unsigned)(t_ >> 32); } \
    if ((p) == MK_TS_TO + 1) { const unsigned long long t_ = __builtin_amdgcn_s_memrealtime(); MISC[18] = (unsigned)t_; MISC[19] = (unsigned)(t_ >> 32); } } } while (0)
#else
#define TS_HOOK(p) do { } while (0)
#endif
#define PHASE_BEGIN(p) if (((MK_CMASK >> (p)) & 1u) && (phmask & (1u << (p)))) { for (int rr_ = 0; rr_ <= (((p) == MK_REP_PHASE) ? MK_REP_COUNT : 0); ++rr_) { if (pending) { xcd_barrier(bar, F.wave); pending = false; } TS_HOOK(p);
#define PHASE_END(p) __syncthreads(); if (args.use_bar && (!((NOBAR_AFTER >> (p)) & 1u) || ((p) == MK_REP_PHASE && rr_ < MK_REP_COUNT))) pending = true; } }

    PHASE_BEGIN(PH_PREP_FFN1) ph_prep_ffn1(F); PHASE_END(PH_PREP_FFN1)

    PHASE_BEGIN(PH_FFN1_GU) {
        pg8::Gemm g{XB, (const bf16*)(ws + WS_WGU), M, 2 * DFF, DM}; pg8::StaticOrder S; S.init(M, 2 * DFF, F.G, (int)blockIdx.x);
        pg8::EpiSwiglu<-1> E{ws};
        pg8::gemm_phase<pg8::EpiSwiglu<-1>, pg8::StaticOrder, true, true>(F.lds, g, S, E, F.wave);
        __syncthreads();
        { int wk, nwk; if (light_worker((M / 256) * (2 * DFF / 256), F.G, (int)blockIdx.x, wk, nwk)) tail_job_a(F, wk, nwk); }
    } PHASE_END(PH_FFN1_GU)
#ifdef MK_XBAR
    if (args.use_bar) { for (int xb_ = 0; xb_ < MK_XBAR; ++xb_) xcd_barrier(bar, F.wave); }
#endif
    PHASE_BEGIN(PH_FFN1_DOWN) {
        pg8::Gemm g{ACT, (const bf16*)(ws + WS_WD), M, DM, DFF}; pg8::StaticOrder S; S.init(M, DM, F.G, (int)blockIdx.x);
        typedef pg8::EpiResid<RS_X1, 1, true, false> EpiT; EpiT E{ws, F.in[0], F.out};
        pg8::gemm_phase<EpiT, pg8::StaticOrder, true, true>(F.lds, g, S, E, F.wave);
    } PHASE_END(PH_FFN1_DOWN)
    PHASE_BEGIN(PH_WIN) {
        pg8::Gemm g{XB, (const bf16*)(ws + WS_WIN), M, INCP, DM}; pg8::StaticOrder S; S.init(M, INCP, F.G, (int)blockIdx.x);
        pg8::EpiWin E{ws};
        pg8::gemm_phase<pg8::EpiWin, pg8::StaticOrder, true, true>(F.lds, g, S, E, F.wave);
        __syncthreads();
        {
            pg8::Gemm g2{(const bf16*)(ws + WS_MEMN), (const bf16*)(ws + WS_WXKV), MMEM, 1024, DM}; pg8::StaticOrder S2; S2.init(MMEM, 1024, F.G, (int)((blockIdx.x + 16) % F.G));
            typedef pg8::EpiScaleBf16<WS_XKV, 1024, -1, 1> EpiT2; EpiT2 E2{ws};
            pg8::gemm_phase<EpiT2, pg8::StaticOrder, true, true>(F.lds, g2, S2, E2, F.wave);
            __syncthreads();
            if (F.G == 256) { int wk, nwk; if (light_worker((M / 256) * (INCP / 256), F.G, (int)blockIdx.x, wk, nwk) && (int)blockIdx.x < F.G - 16) tail_job_ffn2(F, wk, nwk - 16, 0, FFN2_SPLIT); }
            else tail_job_ffn2(F, (int)blockIdx.x, F.G, 0, FFN2_SPLIT);
        }
    } PHASE_END(PH_WIN)
    PHASE_BEGIN(PH_UP) {
        if (((blockIdx.x >> 3) & 1u) != 0u) { ph_hg_a(F); __syncthreads(); }
        { pg8::Gemm g{(const bf16*)(ws + WS_CQ), (const bf16*)(ws + WS_WQUP), M, 1536, 512}; pg8::StaticOrder S; S.init(M, 1536, F.G, (int)blockIdx.x);
          typedef pg8::EpiScaleBf16<WS_QRAW, 1536, RS_CQ, 512> EpiT; EpiT E{ws};
          pg8::gemm_phase<EpiT, pg8::StaticOrder, true, true>(F.lds, g, S, E, F.wave); }
        __syncthreads();
        { pg8::Gemm g{(const bf16*)(ws + WS_CKV), (const bf16*)(ws + WS_WKVUP), M, KVP, 256}; pg8::StaticOrder S; S.init(M, KVP, F.G, (int)((blockIdx.x + 64) % F.G));
          typedef pg8::EpiScaleBf16<WS_KV, KVP, RS_CKV, 256> EpiT; EpiT E{ws};
          pg8::gemm_phase<EpiT, pg8::StaticOrder, true, true>(F.lds, g, S, E, F.wave); }
        __syncthreads();
        if (((blockIdx.x >> 3) & 1u) == 0u) ph_hg_a(F);
    } PHASE_END(PH_UP)
    PHASE_BEGIN(PH_FINAL_QK) ph_final_qk(F); PHASE_END(PH_FINAL_QK)
    PHASE_BEGIN(PH_FINAL_XK) ph_final_xk(F); PHASE_END(PH_FINAL_XK)
    PHASE_BEGIN(PH_HG_B) ph_hg_b(F); PHASE_END(PH_HG_B)
    PHASE_BEGIN(PH_ATTN) {
        if (((blockIdx.x >> 3) & 1u) != 0u) { if (F.G == 256) hg_c_unit(F, F.vcu); else for (int u = F.vcu; u < 256; u += F.G) hg_c_unit(F, u); }
        {
            const att::bf16* Q = (const att::bf16*)(ws + WS_QRAW); const att::bf16* KVb = (const att::bf16*)(ws + WS_KV);
            float* ML = (float*)(ws + WS_KPE); att::bf16* P1 = (att::bf16*)F.out + (size_t)M * 2048;
            const int nsu = (F.G == 256) ? 2 : (512 + F.G - 1 - F.vcu) / F.G;
            for (int i = 0; i < nsu; ++i) {
                int bh, qb, part;
                if (F.G == 256) { const int s = F.vcu & 7, pr = s >> 1; bh = F.vcu >> 3; part = s & 1; qb = (i == 0) ? 7 - pr : pr; }
                else { const int su = F.vcu + i * F.G; bh = su >> 4; qb = (su >> 1) & 7; part = su & 1; }
                const int b = bh >> 3, h = bh & 7, NT = 4 * (qb + 1); const size_t r0 = (size_t)b * SEQ + (size_t)qb * 256;
                att::bf16* Ob = part ? P1 + r0 * 1024 + h * 128 : (att::bf16*)MIX + r0 * 2048 + h * 128;
                att::attn_body_p<192, 1536, KVP, true, att::ScaleMLA>(Q + r0 * 1536 + h * 192, KVb + (size_t)b * SEQ * KVP + h * 320, KVb + (size_t)b * SEQ * KVP + h * 320 + 192,
                    Ob, part ? 1024 : 2048, 64 * NT, part ? NT / 2 : 0, part ? NT : NT / 2, ML + (((size_t)part * M + r0) * 8 + h) * 2, 16, F.wave, F.ldsg);
            }
        }
        if (((blockIdx.x >> 3) & 1u) == 0u) { if (F.G == 256) hg_c_unit(F, F.vcu); else for (int u = F.vcu; u < 256; u += F.G) hg_c_unit(F, u); }
    } PHASE_END(PH_ATTN)
    PHASE_BEGIN(PH_COMBINE) ph_combine(F); PHASE_END(PH_COMBINE)
    PHASE_BEGIN(PH_WOUT) {
        pg8::Gemm g{MIX, (const bf16*)(ws + WS_WOUT), M, DM, DM}; pg8::StaticOrder S; S.init(M, DM, F.G, (int)blockIdx.x);
        typedef pg8::EpiResid<RS_X2, 2, false, false> EpiT; EpiT E{ws, nullptr, F.out}; pg8::MidScale Mh{16, ws};
        pg8::gemm_phase<EpiT, pg8::StaticOrder, true, true, pg8::MidScale>(F.lds, g, S, E, F.wave, Mh);
    } PHASE_END(PH_WOUT)
    PHASE_BEGIN(PH_XQ) {
        { pg8::Gemm g{XB, (const bf16*)(ws + WS_WXQ), M, 512, 1024, DM}; pg8::StaticOrder S; S.init(M, 512, F.G, (int)blockIdx.x);
          typedef pg8::EpiF32<WS_XQP, 512> EpiT; EpiT E{ws};
          pg8::gemm_phase<EpiT, pg8::StaticOrder, true, true>(F.lds, g, S, E, F.wave); }
        __syncthreads();
        { pg8::Gemm g{XB + 1024, (const bf16*)(ws + WS_WXQ) + 1024, M, 512, 1024, DM}; pg8::StaticOrder S; S.init(M, 512, F.G, (int)((blockIdx.x + F.G - 64) % F.G));
          typedef pg8::EpiF32<WS_XQP + (size_t)M * 512 * 4, 512> EpiT; EpiT E{ws};
          pg8::gemm_phase<EpiT, pg8::StaticOrder, true, true>(F.lds, g, S, E, F.wave); }
        __syncthreads();
        if ((int)blockIdx.x >= 128 || F.G != 256) { const int wk = (F.G == 256) ? (int)blockIdx.x - 128 : (int)blockIdx.x, nwk = (F.G == 256) ? 128 : F.G; tail_job_ffn2(F, wk, nwk, FFN2_SPLIT, 2 * I_FFN_G + I_FFN_D / 2); }
    } PHASE_END(PH_XQ)
    PHASE_BEGIN(PH_XATTN) {
        for (int u = F.vcu; u < 128; u += F.G) { const int bh = u >> 3, qb = u & 7, b = bh >> 2, h = bh & 3; const size_t r0 = (size_t)b * SEQ + (size_t)qb * 256;
            const float* Q = (const float*)(ws + WS_XQP); const att::bf16* KVb = (const att::bf16*)(ws + WS_XKV);
            att::attn_body<128, 512, 1024, 512, false, true, false, 2, att::ScaleX>(Q + r0 * 512 + h * 128, KVb + (size_t)b * MEML * 1024 + h * 256, KVb + (size_t)b * MEML * 1024 + h * 256 + 128,
                (att::bf16*)(ws + WS_XO) + r0 * 512 + h * 128, MEML, F.in[23], nullptr, F.wave, F.ldsg); }
        if (F.vcu >= 128 || F.G != 256) { const int wk = (F.G == 256) ? F.vcu - 128 : F.vcu, nwk = (F.G == 256) ? 128 : F.G; tail_job_ffn2(F, wk, nwk, 2 * I_FFN_G + I_FFN_D / 2, 3 * I_FFN_G); }
    } PHASE_END(PH_XATTN)
    PHASE_BEGIN(PH_XO) {
        pg8::Gemm g{(const bf16*)(ws + WS_XO), (const bf16*)(ws + WS_WXO), M, DM, 512}; pg8::StaticOrder S; S.init(M, DM, F.G, (int)blockIdx.x);
        typedef pg8::EpiResid<RS_X3, 2, false, false> EpiT; EpiT E{ws, nullptr, F.out};
        pg8::gemm_phase<EpiT, pg8::StaticOrder, true, true>(F.lds, g, S, E, F.wave);
    } PHASE_END(PH_XO)
    PHASE_BEGIN(PH_FFN2_GU) {
        pg8::Gemm g{XB, (const bf16*)(ws + WS_W2GU), M, 2 * DFF, DM}; pg8::HalfTailOrder S; S.init(M, 2 * DFF, F.G, (int)blockIdx.x);
        pg8::EpiSwiglu<RS_X3> E{ws};
        pg8::gemm_phase<pg8::EpiSwiglu<RS_X3>, pg8::HalfTailOrder, true, true, pg8::NoMid, true>(F.lds, g, S, E, F.wave);
        __syncthreads();
    } PHASE_END(PH_FFN2_GU)
    PHASE_BEGIN(PH_FFN2_DOWN) {
        pg8::Gemm g{ACT, (const bf16*)(ws + WS_W2D), M, DM, DFF}; pg8::StaticOrder S; S.init(M, DM, F.G, (int)blockIdx.x);
        typedef pg8::EpiResid<-1, 1, false, true> EpiT; EpiT E{ws, nullptr, F.out};
        pg8::gemm_phase<EpiT, pg8::StaticOrder, true, true>(F.lds, g, S, E, F.wave);
    } PHASE_END(PH_FFN2_DOWN)
#ifdef MK_TS_FROM
    if (args.use_bar) { xcd_barrier(bar, F.wave); TS_HOOK(PH_COUNT);
        if (blockIdx.x == 0 && (F.wave * 64 + lane_id()) == 0) { const unsigned long long t0_ = ((unsigned long long)MISC[17] << 32) | MISC[16], t1_ = ((unsigned long long)MISC[19] << 32) | MISC[18];
            const float us_ = (float)(t1_ - t0_) * 0.01f; F.out[MK_TS_IDX] += (us_ - (float)(MK_TS_T0)) * (float)(MK_TS_SCALE); } }
#endif
#undef PHASE_BEGIN
#undef PHASE_END
}

#ifndef MK_SINGLE
#define MK_SINGLE 1
#endif
extern "C" void kernel_launch(void* const* d_in, const int* in_sizes, int n_in, void* d_out, int out_size, void* d_ws, size_t ws_size, hipStream_t stream) {
    static int grid = 0;
    if (grid == 0) {
        if (n_in != 30 || in_sizes[0] != M * DM || out_size != M * DM || ws_size < WS_END) { fprintf(stderr, "kernel_launch: unexpected shapes / workspace (%d inputs, ws %zu)\n", n_in, ws_size); grid = -1; return; }
        int dev = 0, cus = 0, per_cu = 0;
        if (hipGetDevice(&dev) != hipSuccess || hipDeviceGetAttribute(&cus, hipDeviceAttributeMultiprocessorCount, dev) != hipSuccess) { grid = -1; return; }
        if (hipFuncSetAttribute((const void*)mk_fwd, hipFuncAttributeMaxDynamicSharedMemorySize, LDS_BYTES) != hipSuccess) { fprintf(stderr, "kernel_launch: hipFuncSetAttribute failed\n"); grid = -1; return; }
        if (hipOccupancyMaxActiveBlocksPerMultiprocessor(&per_cu, (const void*)mk_fwd, NWAVES * 64, LDS_BYTES) != hipSuccess || per_cu < 1) { fprintf(stderr, "kernel_launch: occupancy query says %d blocks/CU\n", per_cu); }
        (void)hipGetLastError();
        grid = cus;
    }
    if (grid < 0) return;
    (void)hipMemsetAsync((char*)d_ws + WS_CTL, 0, CTL_ZERO_BYTES, stream);
    Args a{};
    for (int i = 0; i < 30; ++i) a.in[i] = (const float*)d_in[i];
    a.out = (float*)d_out; a.ws = (unsigned char*)d_ws;
    auto run_phases = [&](unsigned mask) {
        if (MK_SINGLE) { a.phmask = mask; a.use_bar = 1u; hipLaunchKernelGGL(mk_fwd, dim3(grid), dim3(NWAVES * 64), LDS_BYTES, stream, a); }
        else for (int p = 0; p < PH_COUNT; ++p) if (mask & (1u << p)) { a.phmask = 1u << p; a.use_bar = 0u; hipLaunchKernelGGL(mk_fwd, dim3(grid), dim3(NWAVES * 64), LDS_BYTES, stream, a); }
    };
    run_phases((1u << PH_COUNT) - 1u);
}
```

```cpp
#include <hip/hip_runtime.h>
#include <cstdio>
#include <cstdint>
#include <cmath>

#ifndef MK_REP_PHASE
#define MK_REP_PHASE -1
#endif
#ifndef MK_REP_COUNT
#define MK_REP_COUNT 0
#endif
constexpr int NWAVES = 8;
constexpr int BATCH = 4, SEQ = 2048, DM = 2048, M = BATCH * SEQ, DFF = 5504, MEML = 256, MMEM = BATCH * MEML;
constexpr int INC = 4928, INCP = 5120;
constexpr int KVP = 2560;
constexpr float EPS = 1e-6f;
constexpr size_t MiB = 1u << 20;
constexpr size_t WS_CTL = 0, CTL_ZERO_BYTES = 256 * 1024;
constexpr size_t WS_LB = 1 * MiB, WS_ROPE = 2 * MiB, WS_KPE = 4 * MiB, WS_DV = 6 * MiB, WS_MEMN = 7 * MiB, WS_XKV = 11 * MiB;
constexpr size_t WS_WXQ = 13 * MiB, WS_WXKV = 15 * MiB, WS_WXO = 19 * MiB, WS_WQUP = 21 * MiB, WS_WKVUP = 23 * MiB, WS_WOUT = 25 * MiB, WS_WIN = 33 * MiB;
constexpr size_t WS_R1 = 53 * MiB;
constexpr size_t WS_WGU = WS_R1, WS_WD = WS_R1 + 43 * MiB, WS_QRAW = WS_R1, WS_KV = WS_R1 + 24 * MiB;
constexpr size_t WS_ACT = 118 * MiB;
constexpr size_t WS_HQ = WS_ACT, WS_LF = WS_ACT + 16 * MiB, WS_HI = WS_ACT + 48 * MiB, WS_HG = WS_ACT + 64 * MiB;
constexpr size_t WS_XB = 204 * MiB;
constexpr size_t WS_MIX = 236 * MiB, WS_CQ = WS_MIX, WS_CKV = WS_MIX + 8 * MiB;
constexpr size_t WS_DS = 268 * MiB, WS_XO = WS_DS + 8 * MiB, WS_XQP = WS_DS + 16 * MiB;
constexpr size_t WS_XQ_UNUSED = WS_DS;
constexpr size_t WS_W2GU = 332 * MiB, WS_W2D = 375 * MiB;
constexpr size_t WS_END = 397 * MiB;
constexpr int CW_BAR = 4096;
constexpr int CW_RS = 16384;
constexpr int RS_X1 = 0, RS_CQ = 1, RS_CKV = 2, RS_O = 3, RS_X2 = 4, RS_X3 = 5;
static_assert((CW_RS + 6 * M) * 4 <= (int)CTL_ZERO_BYTES, "CTL region");
constexpr int RING_BYTES = 131072, LDSCTL_OFF = RING_BYTES, MISC_OFF = LDSCTL_OFF + 320, LDS_BYTES = 147456;

__device__ __forceinline__ int lane_id() { int l; asm volatile("v_mbcnt_lo_u32_b32 %0, -1, 0\n\tv_mbcnt_hi_u32_b32 %0, -1, %0" : "=v"(l)); return l; }

namespace pg8 {
#define PG8_LAS __attribute__((address_space(3)))
typedef unsigned short bf16_t;
typedef short bf16x8 __attribute__((ext_vector_type(8)));
typedef float f32x4 __attribute__((ext_vector_type(4)));
typedef unsigned u32x4 __attribute__((ext_vector_type(4)));
constexpr int BM = 256, BK = 64, HALF = 128, HTB = HALF * BK * 2  , STAGE_BYTES = 8 * HTB, NXCD = 8, WGM = 8;

__host__ __device__ __forceinline__ int lds_byte(int r, int c) { const int st = (r >> 4) * 2 + (c >> 5), rr = r & 15, cc = c & 31, ob = rr * 64 + cc * 2; return st * 1024 + (ob ^ (((ob >> 9) & 1) << 5)); }
__host__ __device__ __forceinline__ void stage_rc(int b, int& R, int& C) { const int st = b / 1024, sb = b % 1024, swz = sb ^ (((sb >> 9) & 1) << 5); R = (st >> 1) * 16 + swz / 64; C = (st & 1) * 32 + (swz % 64) / 2; }
__host__ __device__ __forceinline__ int perm32(int rho) { const int n = rho >> 4, i = rho & 15; return 8 * (i >> 2) + 4 * n + (i & 3); }

struct Unit { int pm, pn, half; };
struct Gemm { const bf16_t* A; const bf16_t* Bt; int M, N, K, ld; };

struct StaticOrder {
    int nM, nN, nwg, G, c;
    __host__ __device__ void init(int M, int N, int G_, int c_) { nM = M / BM; nN = N / BM; nwg = nM * nN; G = G_; c = c_; }
    __host__ __device__ bool next(int i, Unit& u) const { return at((long)i * G + c, u); }
    __host__ __device__ bool at(long L, Unit& u) const {
        if (L >= nwg) return false;
        u.half = 0; int wgid = (int)L; { const int q = nwg / NXCD, r = nwg % NXCD, xcd = wgid % NXCD, off = wgid / NXCD; wgid = (xcd < r ? xcd * (q + 1) : r * (q + 1) + (xcd - r) * q) + off; }
        const int nig = WGM * nN, gid = wgid / nig, fm = gid * WGM, gsz = (nM - fm) < WGM ? (nM - fm) : WGM;
        u.pm = fm + ((wgid % nig) % gsz); u.pn = (wgid % nig) / gsz; return true;
    }
    __device__ __forceinline__ void a_ready(const Unit&) const {}
    __device__ __forceinline__ void done(const Unit&) const {}
};

struct HalfTailOrder : StaticOrder {
    __host__ __device__ bool next(int i, Unit& u) const {
        const int rounds = (nwg + G - 1) / G, rem = nwg - (rounds - 1) * G;
        if (rem < G && 2 * rem <= G && i == rounds - 1) { const int j = c >> 1; if (j >= rem) return false; if (!at((long)(rounds - 1) * G + j, u)) return false; u.half = 1 + (c & 1); return true; }
        return at((long)i * G + c, u);
    }
};


#define PG8_GAS __attribute__((address_space(1)))
__device__ __forceinline__ void atomic_addf(float* p, float v) { (void)__hip_atomic_fetch_add((PG8_GAS float*)p, v, __ATOMIC_RELAXED, __HIP_MEMORY_SCOPE_AGENT); }
typedef float f32x2_t __attribute__((ext_vector_type(2))); typedef __bf16 bf16x2_t __attribute__((ext_vector_type(2)));
__device__ __forceinline__ unsigned cvtpk(float lo, float hi) { f32x2_t v = {lo, hi}; bf16x2_t b = __builtin_convertvector(v, bf16x2_t); return __builtin_bit_cast(unsigned, b); }
__device__ __forceinline__ float fsigmoid(float x) { return __builtin_amdgcn_rcpf(1.0f + __builtin_amdgcn_exp2f(-1.4426950408889634f * x)); }
__device__ __forceinline__ float rstd_of(float ss, float inv_n) { return 1.0f / sqrtf(ss * inv_n + 1e-6f); }
__device__ __forceinline__ u32x4 pack8(const f32x4 a, const f32x4 b) { u32x4 w; w.x = cvtpk(a[0], a[1]); w.y = cvtpk(a[2], a[3]); w.z = cvtpk(b[0], b[1]); w.w = cvtpk(b[2], b[3]); return w; }
__device__ __forceinline__ float dot4(const f32x4 a) { return (a[0] * a[0] + a[1] * a[1]) + (a[2] * a[2] + a[3] * a[3]); }
constexpr float rs_div(int idx) { return (MK_REP_COUNT > 0 && ((idx == RS_X1 && MK_REP_PHASE == 2) || ((idx == RS_CQ || idx == RS_CKV) && MK_REP_PHASE == 3))) ? 1.0f / (1 + MK_REP_COUNT) : 1.0f; }
__device__ __forceinline__ float* rs_ptr(unsigned char* ws, int idx) { return (float*)(ws + WS_CTL) + CW_RS + idx * M; }
#define PG8_EPI_ENTER int fr = fr_, fq = fq_; unsigned char* w = ws; asm volatile("" : "+v"(fr), "+v"(fq), "+s"(w));

template <int RSI> struct EpiSwiglu {
    static constexpr bool PERM = true, AFTER_DRAIN = false;
    unsigned char* ws;
    __device__ __forceinline__ void operator()(const f32x4 (&acc)[2][2][4][2], const Unit& u, int wr, int wc, int fr_, int fq_) const {
        PG8_EPI_ENTER
        bf16_t* O = (bf16_t*)(w + WS_ACT); const float* rs = RSI >= 0 ? rs_ptr(w, RSI) : nullptr;
        const int row0 = u.pm * BM + (u.half == 2 ? HALF : 0) + wr * 64 + fr, col0 = u.pn * HALF + wc * 32 + 8 * fq;
#pragma unroll
        for (int ai = 0; ai < 2; ++ai)
#pragma unroll
            for (int m = 0; m < 4; ++m) {
                if (ai == 1 && u.half != 0) continue;
                const int row = row0 + ai * HALF + m * 16;
                const float sc = RSI >= 0 ? rstd_of(rs[row], rs_div(RSI) / DM) : 1.0f;
                f32x4 v[2];
#pragma unroll
                for (int n = 0; n < 2; ++n)
#pragma unroll
                    for (int i = 0; i < 4; ++i) { const float g = acc[ai][0][m][n][i] * sc, uu = acc[ai][1][m][n][i] * sc; v[n][i] = g * fsigmoid(g) * uu; }
                *(PG8_GAS u32x4*)(O + (size_t)row * DFF + col0) = pack8(v[0], v[1]);
            }
    }
};
template <int RSI, int ALPHA2, bool BASE_X, bool OUT_F32> struct EpiResid {
    static constexpr bool PERM = true, AFTER_DRAIN = false;
    unsigned char* ws; const float* x; float* out;
    __device__ __forceinline__ void operator()(const f32x4 (&acc)[2][2][4][2], const Unit& u, int wr, int wc, int fr_, int fq_) const {
        PG8_EPI_ENTER
        constexpr float alpha = 0.5f * ALPHA2;
        bf16_t* xb = (bf16_t*)(w + WS_XB); float* rs = rs_ptr(w, RSI >= 0 ? RSI : 0);
        const int row0 = u.pm * BM + wr * 64 + fr, col0 = u.pn * BM + wc * 32 + 8 * fq;
#pragma unroll
        for (int ai = 0; ai < 2; ++ai)
#pragma unroll
            for (int m = 0; m < 4; ++m) {
                const int row = row0 + ai * HALF + m * 16; const size_t off = (size_t)row * DM + col0; float ss = 0.f;
#pragma unroll
                for (int bj = 0; bj < 2; ++bj) {
                    f32x4 b0, b1;
                    if (BASE_X) { b0 = __builtin_nontemporal_load((const PG8_GAS f32x4*)(x + off + bj * HALF)); b1 = __builtin_nontemporal_load((const PG8_GAS f32x4*)(x + off + bj * HALF + 4)); }
                    else { const u32x4 bw = *(const PG8_GAS u32x4*)(xb + off + bj * HALF);
                        b0 = (f32x4){__uint_as_float(bw.x << 16), __uint_as_float(bw.x & 0xffff0000u), __uint_as_float(bw.y << 16), __uint_as_float(bw.y & 0xffff0000u)};
                        b1 = (f32x4){__uint_as_float(bw.z << 16), __uint_as_float(bw.z & 0xffff0000u), __uint_as_float(bw.w << 16), __uint_as_float(bw.w & 0xffff0000u)}; }
                    const f32x4 o0 = b0 + acc[ai][bj][m][0] * alpha, o1 = b1 + acc[ai][bj][m][1] * alpha;
                    if (OUT_F32) { *(PG8_GAS f32x4*)(out + off + bj * HALF) = o0; *(PG8_GAS f32x4*)(out + off + bj * HALF + 4) = o1; }
                    if (RSI >= 0) { ss += dot4(o0) + dot4(o1); *(PG8_GAS u32x4*)(xb + off + bj * HALF) = pack8(o0, o1); }
                }
                if (RSI >= 0) { ss += __shfl_xor(ss, 16); ss += __shfl_xor(ss, 32); if (fq == 0) atomic_addf(rs + row, ss); }
            }
    }
};
template <size_t O_OFF, int LDO, int RSI, int WIDTH> struct EpiScaleBf16 {
    static constexpr bool PERM = true, AFTER_DRAIN = false;
    unsigned char* ws;
    __device__ __forceinline__ void operator()(const f32x4 (&acc)[2][2][4][2], const Unit& u, int wr, int wc, int fr_, int fq_) const {
        PG8_EPI_ENTER
        bf16_t* O = (bf16_t*)(w + O_OFF); const float* rs = rs_ptr(w, RSI >= 0 ? RSI : 0);
        const int row0 = u.pm * BM + wr * 64 + fr, col0 = u.pn * BM + wc * 32 + 8 * fq;
#pragma unroll
        for (int ai = 0; ai < 2; ++ai)
#pragma unroll
            for (int m = 0; m < 4; ++m) {
                const int row = row0 + ai * HALF + m * 16;
                const float sc = RSI >= 0 ? rstd_of(rs[row], rs_div(RSI) / WIDTH) : 1.0f;
#pragma unroll
                for (int bj = 0; bj < 2; ++bj) *(PG8_GAS u32x4*)(O + (size_t)row * LDO + col0 + bj * HALF) = pack8(acc[ai][bj][m][0] * sc, acc[ai][bj][m][1] * sc);
            }
    }
};
template <size_t O_OFF, int LDO> struct EpiF32 {
    static constexpr bool PERM = true, AFTER_DRAIN = false;
    unsigned char* ws;
    __device__ __forceinline__ void operator()(const f32x4 (&acc)[2][2][4][2], const Unit& u, int wr, int wc, int fr_, int fq_) const {
        PG8_EPI_ENTER
        float* O = (float*)(w + O_OFF);
        const int row0 = u.pm * BM + wr * 64 + fr, col0 = u.pn * BM + wc * 32 + 8 * fq;
#pragma unroll
        for (int ai = 0; ai < 2; ++ai)
#pragma unroll
            for (int m = 0; m < 4; ++m) { const int row = row0 + ai * HALF + m * 16;
#pragma unroll
                for (int bj = 0; bj < 2; ++bj) { *(PG8_GAS f32x4*)(O + (size_t)row * LDO + col0 + bj * HALF) = acc[ai][bj][m][0]; *(PG8_GAS f32x4*)(O + (size_t)row * LDO + col0 + bj * HALF + 4) = acc[ai][bj][m][1]; } }
    }
};
struct EpiWin {
    static constexpr bool PERM = true, AFTER_DRAIN = false;
    unsigned char* ws;
    __device__ __forceinline__ void operator()(const f32x4 (&acc)[2][2][4][2], const Unit& u, int wr, int wc, int fr_, int fq_) const {
        PG8_EPI_ENTER
        const float* rs1 = rs_ptr(w, RS_X1); constexpr float inv_n = rs_div(RS_X1) / DM;
        const int row0 = u.pm * BM + wr * 64 + fr, cw = wc * 32 + 8 * fq, pn = u.pn;
        if (pn == 3) {
            float* KPE = (float*)(w + WS_KPE);
            if (wc < 2) {
#pragma unroll
                for (int ai = 0; ai < 2; ++ai)
#pragma unroll
                    for (int m = 0; m < 4; ++m) { const int row = row0 + ai * HALF + m * 16; const float sc = rstd_of(rs1[row], inv_n);
                        *(PG8_GAS f32x4*)(KPE + (size_t)row * 64 + cw) = acc[ai][0][m][0] * sc; *(PG8_GAS f32x4*)(KPE + (size_t)row * 64 + cw + 4) = acc[ai][0][m][1] * sc; }
            }
            return;
        }
        if (pn >= 8 && pn < 12) {
            float* LF = (float*)(w + WS_LF); const float* LB = (const float*)(w + WS_LB);
            const int cb = (pn - 8) * BM + cw;
            f32x4 lb[2][2];
#pragma unroll
            for (int bj = 0; bj < 2; ++bj)
#pragma unroll
                for (int n = 0; n < 2; ++n) lb[bj][n] = *(const PG8_GAS f32x4*)(LB + cb + bj * HALF + 4 * n);
#pragma unroll
            for (int ai = 0; ai < 2; ++ai)
#pragma unroll
                for (int m = 0; m < 4; ++m) { const int row = row0 + ai * HALF + m * 16; const float sc = rstd_of(rs1[row], inv_n);
#pragma unroll
                    for (int bj = 0; bj < 2; ++bj)
#pragma unroll
                        for (int n = 0; n < 2; ++n) { f32x4 o;
#pragma unroll
                            for (int i = 0; i < 4; ++i) { const float l = lb[bj][n][i]; const float f = l + (1.0f - l) * fsigmoid(acc[ai][bj][m][n][i] * sc); o[i] = __builtin_amdgcn_logf(f) * 0.6931471805599453f; }
                            *(PG8_GAS f32x4*)(LF + (size_t)row * 1024 + cb + bj * HALF + 4 * n) = o; } }
            return;
        }
        bf16_t* ob; int ldo, cb; float* rsq = nullptr;
        if (pn < 2) { ob = (bf16_t*)(w + WS_CQ); ldo = 512; cb = pn * BM; rsq = rs_ptr(w, RS_CQ); }
        else if (pn == 2) { ob = (bf16_t*)(w + WS_CKV); ldo = 256; cb = 0; rsq = rs_ptr(w, RS_CKV); }
        else if (pn < 8) { ob = (bf16_t*)(w + WS_HQ); ldo = 1024; cb = (pn - 4) * BM; }
        else if (pn < 16) { ob = (bf16_t*)(w + WS_HI); ldo = 1024; cb = (pn - 12) * BM; }
        else { ob = (bf16_t*)(w + WS_HG); ldo = 1024; cb = (pn - 16) * BM; }
#pragma unroll
        for (int ai = 0; ai < 2; ++ai)
#pragma unroll
            for (int m = 0; m < 4; ++m) { const int row = row0 + ai * HALF + m * 16; const float sc = rstd_of(rs1[row], inv_n); float ss = 0.f;
#pragma unroll
                for (int bj = 0; bj < 2; ++bj) { const f32x4 v0 = acc[ai][bj][m][0] * sc, v1 = acc[ai][bj][m][1] * sc; ss += dot4(v0) + dot4(v1);
                    *(PG8_GAS u32x4*)(ob + (size_t)row * ldo + cb + cw + bj * HALF) = pack8(v0, v1); }
                if (rsq) { ss += __shfl_xor(ss, 16); ss += __shfl_xor(ss, 32); if (fq == 0) atomic_addf(rsq + row, ss); } }
    }
};
struct MidScale {
    static constexpr bool ON = true; int t_at; unsigned char* ws;
    __device__ __forceinline__ void apply(f32x4 (&acc)[2][2][4][2], const Unit& u, int wr, int fr_) const {
        int fr = fr_; unsigned char* w = ws; asm volatile("" : "+v"(fr), "+s"(w));
        const float* rs = rs_ptr(w, RS_O);
#pragma unroll
        for (int ai = 0; ai < 2; ++ai)
#pragma unroll
            for (int m = 0; m < 4; ++m) { const float s = rstd_of(rs[u.pm * BM + ai * HALF + wr * 64 + m * 16 + fr], rs_div(RS_O) / 1024.0f);
#pragma unroll
                for (int bj = 0; bj < 2; ++bj)
#pragma unroll
                    for (int n = 0; n < 2; ++n) acc[ai][bj][m][n] *= s; }
    }
};

struct NoMid { static constexpr bool ON = false; int t_at; __device__ __forceinline__ void apply(f32x4 (&)[2][2][4][2], const Unit&, int, int) const {} };
template <class Epi, class Sched, bool ALIGN_EPI = false, bool SP2 = false, class Mid = NoMid, bool HALFU = false, int AUX_A = 0, int AUX_B = 0>
__device__ __forceinline__ void gemm_phase(PG8_LAS unsigned char* lds, const Gemm g, const Sched& S, const Epi& E, const int wave_, const Mid& Mh = Mid()) {
    int tid = wave_ * 64 + lane_id(); asm volatile("" : "+v"(tid));
    const int wid = wave_, lane = tid & 63, wr = wid >> 2, wc = wid & 3, fr = lane & 15, fq = lane >> 4;
    const int K = g.K, nt = K / BK, LD = g.ld ? g.ld : g.K;
    unsigned voffA[2], voffB[2];
#pragma unroll
    for (int i = 0; i < 2; ++i) { int R, C; stage_rc(tid * 16 + i * 8192, R, C); const int Rb = Epi::PERM ? ((R & ~31) + perm32(R & 31)) : R;
        voffA[i] = (unsigned)(R * LD + C) * 2u; voffB[i] = (unsigned)(Rb * LD + C) * 2u; }
    const size_t kstep = (size_t)(BK * 2);
    const size_t hstep = (size_t)HALF * LD * 2;
    const size_t tstep = 2 * hstep;
    const unsigned ldsw = (unsigned)wid * 1024u;
    const int aoff = lds_byte(wr * 64 + fr, fq * 8), boff = lds_byte(wc * 32 + fr, fq * 8);
#define PG8_SA(b, h) (((b) * 2 + (h)) * HTB)
#define PG8_SB(b, h) ((4 + (b) * 2 + (h)) * HTB)
#define PG8_STAGE(bufoff, gbase, voff) do { _Pragma("unroll") for (int _i = 0; _i < 2; ++_i) \
        __builtin_amdgcn_global_load_lds((const unsigned*)((const char*)(gbase) + (voff)[_i]), (PG8_LAS unsigned*)(lds + (bufoff) + ldsw + _i * 8192), 16, 0, (&(voff)[0] == &voffA[0]) ? AUX_A : AUX_B); } while (0)
#define PG8_LDA(dst, b, h) do { _Pragma("unroll") for (int m = 0; m < 4; ++m) _Pragma("unroll") for (int k = 0; k < 2; ++k) dst[m][k] = *(const PG8_LAS bf16x8*)(lds + PG8_SA(b, h) + aoff + m * 2048 + k * 1024); } while (0)
#define PG8_LDB(dst, b, h) do { _Pragma("unroll") for (int n = 0; n < 2; ++n) _Pragma("unroll") for (int k = 0; k < 2; ++k) dst[n][k] = *(const PG8_LAS bf16x8*)(lds + PG8_SB(b, h) + boff + n * 2048 + k * 1024); } while (0)
#define PG8_MMA(ai, bj, At, Bt) do { __builtin_amdgcn_s_setprio(1); _Pragma("unroll") for (int m = 0; m < 4; ++m) _Pragma("unroll") for (int n = 0; n < 2; ++n) _Pragma("unroll") for (int k = 0; k < 2; ++k) \
        acc[ai][bj][m][n] = __builtin_amdgcn_mfma_f32_16x16x32_bf16(Bt[n][k], At[m][k], acc[ai][bj][m][n], 0, 0, 0); __builtin_amdgcn_s_setprio(0); } while (0)
#define PG8_WAIT_V(n) asm volatile("s_waitcnt vmcnt(" #n ")" ::: "memory")
#define PG8_WAIT_L(n) asm volatile("s_waitcnt lgkmcnt(" #n ")" ::: "memory")
#define PG8_BAR __builtin_amdgcn_s_barrier()
#define PG8_SCHED __builtin_amdgcn_sched_barrier(0)
    Unit cur, nxt; int ui = 0;
    if (!S.next(0, cur)) return;
    f32x4 acc[2][2][4][2];
#pragma unroll
    for (int a = 0; a < 2; ++a)
#pragma unroll
        for (int b = 0; b < 2; ++b)
#pragma unroll
            for (int m = 0; m < 4; ++m)
#pragma unroll
                for (int n = 0; n < 2; ++n) acc[a][b][m][n] = (f32x4){0.f, 0.f, 0.f, 0.f};
    bf16x8 At[4][2], B0[2][2], B1[2][2];
    const char* cA = (const char*)g.A + (size_t)cur.pm * tstep; const char* cB = (const char*)g.Bt + (size_t)cur.pn * tstep;
    size_t hsA = hstep;
    if constexpr (HALFU) { if (cur.half) { hsA = 0; if (cur.half == 2) cA += hstep; } }
    S.a_ready(cur);
    if constexpr (SP2) {
        PG8_STAGE(PG8_SB(0, 0), cB, voffB); PG8_STAGE(PG8_SB(0, 1), cB + hstep, voffB); PG8_STAGE(PG8_SA(0, 0), cA, voffA); PG8_STAGE(PG8_SA(0, 1), cA + hsA, voffA);
        if (wr == 1) PG8_BAR;
        PG8_WAIT_V(2); PG8_BAR;
        PG8_STAGE(PG8_SB(1, 0), cB + kstep, voffB); PG8_STAGE(PG8_SA(1, 0), cA + kstep, voffA); PG8_STAGE(PG8_SB(1, 1), cB + hstep + kstep, voffB);
        PG8_WAIT_V(6); PG8_BAR;
    } else {
        PG8_STAGE(PG8_SB(0, 0), cB, voffB); PG8_STAGE(PG8_SA(0, 0), cA, voffA); PG8_STAGE(PG8_SB(0, 1), cB + hstep, voffB); PG8_STAGE(PG8_SA(0, 1), cA + hstep, voffA);
        if (wr == 1) PG8_BAR;
        PG8_WAIT_V(4); PG8_BAR;
        PG8_STAGE(PG8_SB(1, 0), cB + kstep, voffB); PG8_STAGE(PG8_SA(1, 0), cA + kstep, voffA); PG8_STAGE(PG8_SB(1, 1), cB + hstep + kstep, voffB);
        PG8_WAIT_V(6); PG8_BAR;
    }
    for (;;) {
        const bool has_next = S.next(ui + 1, nxt);
        const char* nA = has_next ? (const char*)g.A + (size_t)nxt.pm * tstep : cA; const char* nB = has_next ? (const char*)g.Bt + (size_t)nxt.pn * tstep : cB;
        size_t hsN = has_next ? hstep : hsA;
        if constexpr (HALFU) { if (has_next && nxt.half) { hsN = 0; if (nxt.half == 2) nA += hstep; } }
        const bool fullu = !HALFU || cur.half == 0;
        for (int t = 0; t < nt; t += 2) {
            if constexpr (Mid::ON) { if (t == Mh.t_at) Mh.apply(acc, cur, wr, fr); }
            const bool last = (t == nt - 2);
            const char* a1 = cA + (size_t)(t + 1) * kstep;
            const char* a2 = last ? nA : cA + (size_t)(t + 2) * kstep; const char* b2 = last ? nB : cB + (size_t)(t + 2) * kstep;
            const char* a3 = a2 + kstep; const char* b3 = b2 + kstep;
            if (last && has_next) S.a_ready(nxt);
            if constexpr (SP2) {
            PG8_LDB(B0, 0, 0); PG8_LDB(B1, 0, 1); PG8_SCHED; PG8_LDA(At, 0, 0); PG8_STAGE(PG8_SA(1, 1), a1 + hsA, voffA);
            PG8_WAIT_V(8); PG8_WAIT_L(0); PG8_BAR; PG8_MMA(0, 0, At, B0); PG8_MMA(0, 1, At, B1); PG8_BAR; PG8_SCHED;
            if (fullu) PG8_LDA(At, 0, 1); PG8_STAGE(PG8_SB(0, 0), b2, voffB); PG8_STAGE(PG8_SB(0, 1), b2 + hstep, voffB); PG8_STAGE(PG8_SA(0, 0), a2, voffA);
            PG8_WAIT_V(8); PG8_WAIT_L(0); PG8_BAR; if (fullu) { PG8_MMA(1, 0, At, B0); PG8_MMA(1, 1, At, B1); } PG8_BAR; PG8_SCHED;
            PG8_LDB(B0, 1, 0); PG8_LDB(B1, 1, 1); PG8_SCHED; PG8_LDA(At, 1, 0); PG8_STAGE(PG8_SA(0, 1), a2 + (last ? hsN : hsA), voffA);
            PG8_WAIT_V(8); PG8_WAIT_L(0); PG8_BAR; PG8_MMA(0, 0, At, B0); PG8_MMA(0, 1, At, B1); PG8_BAR; PG8_SCHED;
            if (fullu) PG8_LDA(At, 1, 1); PG8_STAGE(PG8_SB(1, 0), b3, voffB); PG8_STAGE(PG8_SB(1, 1), b3 + hstep, voffB); PG8_STAGE(PG8_SA(1, 0), a3, voffA);
            PG8_WAIT_V(8); PG8_WAIT_L(0); PG8_BAR; if (fullu) { PG8_MMA(1, 0, At, B0); PG8_MMA(1, 1, At, B1); } PG8_BAR; PG8_SCHED;
            } else {
            PG8_LDB(B0, 0, 0); PG8_SCHED; PG8_LDA(At, 0, 0); PG8_STAGE(PG8_SA(1, 1), a1 + hstep, voffA);
            PG8_WAIT_L(8); PG8_BAR; PG8_WAIT_L(0); PG8_MMA(0, 0, At, B0); PG8_BAR; PG8_SCHED;
            PG8_LDB(B1, 0, 1); PG8_STAGE(PG8_SB(0, 0), b2, voffB);
            PG8_BAR; PG8_WAIT_L(0); PG8_MMA(0, 1, At, B1); PG8_BAR;
            PG8_LDA(At, 0, 1); PG8_STAGE(PG8_SA(0, 0), a2, voffA);
            PG8_BAR; PG8_WAIT_L(0); PG8_MMA(1, 0, At, B0); PG8_BAR; PG8_SCHED;
            PG8_STAGE(PG8_SB(0, 1), b2 + hstep, voffB);
            PG8_WAIT_V(6); PG8_BAR; PG8_MMA(1, 1, At, B1); PG8_BAR;
            PG8_LDB(B0, 1, 0); PG8_SCHED; PG8_LDA(At, 1, 0); PG8_STAGE(PG8_SA(0, 1), a2 + hstep, voffA);
            PG8_WAIT_L(8); PG8_BAR; PG8_WAIT_L(0); PG8_MMA(0, 0, At, B0); PG8_BAR; PG8_SCHED;
            PG8_LDB(B1, 1, 1); PG8_STAGE(PG8_SB(1, 0), b3, voffB);
            PG8_BAR; PG8_WAIT_L(0); PG8_MMA(0, 1, At, B1); PG8_BAR;
            PG8_LDA(At, 1, 1); PG8_STAGE(PG8_SA(1, 0), a3, voffA);
            PG8_BAR; PG8_WAIT_L(0); PG8_MMA(1, 0, At, B0); PG8_BAR; PG8_SCHED;
            PG8_STAGE(PG8_SB(1, 1), b3 + hstep, voffB);
            PG8_WAIT_V(6); PG8_BAR; PG8_MMA(1, 1, At, B1); PG8_BAR;
            }
        }
        if constexpr (ALIGN_EPI) { if (wr == 0) PG8_BAR; }
        if constexpr (!Epi::AFTER_DRAIN) { E(acc, cur, wr, wc, fr, fq); S.done(cur); }
        if (!has_next) break;
#pragma unroll
        for (int a = 0; a < 2; ++a)
#pragma unroll
            for (int b = 0; b < 2; ++b)
#pragma unroll
                for (int m = 0; m < 4; ++m)
#pragma unroll
                    for (int n = 0; n < 2; ++n) acc[a][b][m][n] = (f32x4){0.f, 0.f, 0.f, 0.f};
        cur = nxt; cA = nA; cB = nB; hsA = hsN; ++ui;
        if constexpr (ALIGN_EPI) { if (wr == 1) PG8_BAR; }
    }
    PG8_WAIT_V(0);
    if constexpr (!ALIGN_EPI) { if (wr == 0) PG8_BAR; }
    PG8_BAR;
    if constexpr (Epi::AFTER_DRAIN) { E.fused(acc, cur, wr, wc, fr, fq, lds, wid, lane); S.done(cur); }
#undef PG8_SA
#undef PG8_SB
#undef PG8_STAGE
#undef PG8_LDA
#undef PG8_LDB
#undef PG8_MMA
#undef PG8_WAIT_V
#undef PG8_WAIT_L
#undef PG8_BAR
#undef PG8_SCHED
}
}


using pg8::cvtpk;
__device__ __forceinline__ float bflo(unsigned w) { return __uint_as_float(w << 16); }
__device__ __forceinline__ float bfhi(unsigned w) { return __uint_as_float(w & 0xffff0000u); }

namespace att {
using bf16 = unsigned short;
using bf16x8 = __attribute__((ext_vector_type(8))) short;
using s16x4  = __attribute__((ext_vector_type(4))) short;
using f32x16 = __attribute__((ext_vector_type(16))) float;
using f32x4  = __attribute__((ext_vector_type(4))) float;
using u32x4  = __attribute__((ext_vector_type(4))) unsigned;
using u32x2  = __attribute__((ext_vector_type(2))) unsigned;
constexpr int NW = 8, QBLK = 32, KVBLK = 64;
#define SBAR() __builtin_amdgcn_sched_barrier(0)
__device__ __forceinline__ int crow(int r, int hi) { return (r & 3) + 8 * (r >> 2) + 4 * hi; }
template <int DQK> __device__ __forceinline__ int kswz(int row, int colB) {
  if (DQK == 128) return row * 256 + (colB ^ ((row & 7) << 4));
  else return row * (DQK * 2 + 16) + colB;
}
template <class SC>
__device__ __forceinline__ void partialSM(f32x16& p0, f32x16& p1, float& m_reg, float& mn, float& alpha) {
  constexpr float SCALE = SC::S, THR = SC::T;
  constexpr float C = SCALE * 1.4426950408889634f;
  float pmax = p0[0];
#pragma unroll
  for (int r = 1; r < 16; ++r) pmax = fmaxf(pmax, p0[r]);
#pragma unroll
  for (int r = 0; r < 16; ++r) pmax = fmaxf(pmax, p1[r]);
  { auto rr = __builtin_amdgcn_permlane32_swap(__float_as_uint(pmax), __float_as_uint(pmax), false, false);
    pmax = fmaxf(__uint_as_float(rr[0]), __uint_as_float(rr[1])); }
  if (__builtin_expect(__all(pmax - m_reg <= THR / SCALE), 1)) { mn = m_reg; alpha = 1.f; }
  else { mn = fmaxf(m_reg, pmax); alpha = __builtin_amdgcn_exp2f((m_reg - mn) * C); m_reg = mn; }
  const float mnC = -mn * C;
#pragma unroll
  for (int r = 0; r < 16; ++r) p0[r] = fmaf(p0[r], C, mnC);
#pragma unroll
  for (int r = 0; r < 16; ++r) p1[r] = fmaf(p1[r], C, mnC);
#pragma unroll
  for (int r = 0; r < 16; ++r) p0[r] = __builtin_amdgcn_exp2f(p0[r]);
}
#define ATT_PK4(P, BASE, OUT) do { unsigned a0 = cvtpk(P[BASE + 0], P[BASE + 1]), a1 = cvtpk(P[BASE + 2], P[BASE + 3]);   \
    unsigned b0 = cvtpk(P[BASE + 4], P[BASE + 5]), b1 = cvtpk(P[BASE + 6], P[BASE + 7]);                              \
    auto r0 = __builtin_amdgcn_permlane32_swap(a0, b0, false, false); auto r1 = __builtin_amdgcn_permlane32_swap(a1, b1, false, false); \
    u32x4 w = {r0[0], r1[0], r0[1], r1[1]}; OUT = *reinterpret_cast<bf16x8*>(&w); } while (0)
__device__ __forceinline__ void pack_p(f32x16& p0, f32x16& p1, bf16x8& pa0, bf16x8& pa1, bf16x8& pa2, bf16x8& pa3) {
  ATT_PK4(p0, 0, pa0); ATT_PK4(p0, 8, pa1); ATT_PK4(p1, 0, pa2); ATT_PK4(p1, 8, pa3);
}
__device__ __forceinline__ void finishSM(f32x16& p0, f32x16& p1, float alpha, float& l_reg, bf16x8& pa0, bf16x8& pa1, bf16x8& pa2, bf16x8& pa3) {
#pragma unroll
  for (int r = 0; r < 16; ++r) p1[r] = __builtin_amdgcn_exp2f(p1[r]);
  float ps = 0;
#pragma unroll
  for (int r = 0; r < 16; ++r) ps += p0[r];
#pragma unroll
  for (int r = 0; r < 16; ++r) ps += p1[r];
  { auto rr = __builtin_amdgcn_permlane32_swap(__float_as_uint(ps), __float_as_uint(ps), false, false);
    ps = __uint_as_float(rr[0]) + __uint_as_float(rr[1]); }
  l_reg = l_reg * alpha + ps;
  pack_p(p0, p1, pa0, pa1, pa2, pa3);
}
template <int DQK> __device__ __forceinline__ void qkt(f32x16& p0, f32x16& p1, const char* Ks, const bf16x8* qr, int r32, int hi) {
  p0 = f32x16{}; p1 = f32x16{};
#pragma unroll
  for (int d0 = 0; d0 < DQK / 16; ++d0) { const int cb = (d0 * 16 + hi * 8) * 2;
    if (DQK > 128 && d0 > 0 && (d0 & 3) == 0) SBAR();
    const bf16x8 b0 = *reinterpret_cast<const bf16x8*>(Ks + kswz<DQK>(r32, cb));
    const bf16x8 b1 = *reinterpret_cast<const bf16x8*>(Ks + kswz<DQK>(32 + r32, cb));
    p0 = __builtin_amdgcn_mfma_f32_32x32x16_bf16(b0, qr[d0], p0, 0, 0, 0);
    p1 = __builtin_amdgcn_mfma_f32_32x32x16_bf16(b1, qr[d0], p1, 0, 0, 0); }
}
__device__ __forceinline__ int v_st(int k, int c) { const int kk = (k & ~0xC) | ((k & 4) << 1) | ((k & 8) >> 1); return ((kk >> 3) * 4 + (c >> 5)) * 512 + ((kk & 7) * 32 + (c & 31)) * 2; }
__device__ __forceinline__ int v_rd_base(int lane) { return ((lane & 3) << 3) | (((lane >> 2) & 3) << 6) | (((lane >> 4) & 1) << 5) | (((lane >> 5) & 1) << 8); }
constexpr int v_rd_off(int d0, int ks, int half) { return d0 * 512 + ks * 4096 + half * 2048; }
template <int OFF> __device__ __forceinline__ s16x4 tr_read(int vb) {
  s16x4 r; asm volatile("ds_read_b64_tr_b16 %0, %1 offset:%2" : "=&v"(r) : "v"(vb), "i"(OFF) : "memory"); return r;
}
#define ATT_PK(L, H) (bf16x8){L[0], L[1], L[2], L[3], H[0], H[1], H[2], H[3]}
template <int D0> __device__ __forceinline__ void pv_one(f32x16& od, int vb, bf16x8 pa0, bf16x8 pa1, bf16x8 pa2, bf16x8 pa3) {
  const s16x4 l0 = tr_read<v_rd_off(D0, 0, 0)>(vb), h0 = tr_read<v_rd_off(D0, 0, 1)>(vb), l1 = tr_read<v_rd_off(D0, 1, 0)>(vb), h1 = tr_read<v_rd_off(D0, 1, 1)>(vb);
  const s16x4 l2 = tr_read<v_rd_off(D0, 2, 0)>(vb), h2 = tr_read<v_rd_off(D0, 2, 1)>(vb), l3 = tr_read<v_rd_off(D0, 3, 0)>(vb), h3 = tr_read<v_rd_off(D0, 3, 1)>(vb);
  asm volatile("s_waitcnt lgkmcnt(0)" ::: "memory"); SBAR();
  od = __builtin_amdgcn_mfma_f32_32x32x16_bf16(pa0, ATT_PK(l0, h0), od, 0, 0, 0);
  od = __builtin_amdgcn_mfma_f32_32x32x16_bf16(pa1, ATT_PK(l1, h1), od, 0, 0, 0);
  od = __builtin_amdgcn_mfma_f32_32x32x16_bf16(pa2, ATT_PK(l2, h2), od, 0, 0, 0);
  od = __builtin_amdgcn_mfma_f32_32x32x16_bf16(pa3, ATT_PK(l3, h3), od, 0, 0, 0);
}
__device__ __forceinline__ void pv_d0(f32x16* o, int vb, bf16x8 pa0, bf16x8 pa1, bf16x8 pa2, bf16x8 pa3) {
  pv_one<0>(o[0], vb, pa0, pa1, pa2, pa3); pv_one<1>(o[1], vb, pa0, pa1, pa2, pa3); pv_one<2>(o[2], vb, pa0, pa1, pa2, pa3); pv_one<3>(o[3], vb, pa0, pa1, pa2, pa3);
}
__device__ __forceinline__ void cmask(f32x16& p0, f32x16& p1, int jb, int qrel, int hi) {
  const float NEG = -INFINITY; const int kb = 64 * jb + 4 * hi;
#pragma unroll
  for (int r = 0; r < 16; ++r) { const int kv = kb + (r & 3) + 8 * (r >> 2); if (kv > qrel) p0[r] = NEG; if (kv + 32 > qrel) p1[r] = NEG; }
}
struct ScaleMLA { static constexpr float S = 0.07216878364870322f; static constexpr float T = 8.f; };
struct ScaleX   { static constexpr float S = 0.08838834764831845f; static constexpr float T = 8.f; };

template <int DQK, int LDQ, int LDK, int LDO, bool CAUSAL, bool QNORM, bool ROWSQ, int SDEPTH, class SC>
__device__ __forceinline__ void attn_body(const float* __restrict__ Qb, const bf16* __restrict__ Kh, const bf16* __restrict__ Vh, bf16* __restrict__ Ob, int seq,
                                          const float* __restrict__ qg, float* rs, const int wave_, char* lds) {
  constexpr int ND = DQK / 16, NKC = DQK / 8, KCH = (64 * NKC) / 512;
  constexpr int SHM_V = KVBLK * 128 * 2, SHM_K = KVBLK * (DQK == 128 ? 256 : DQK * 2 + 16);
  int tid = wave_ * 64 + lane_id(); asm volatile("" : "+v"(tid));
  const int wid = wave_, lane = tid & 63, r32 = lane & 31, hi = lane >> 5;
  char* V_lds = lds; char* K_lds = lds + 2 * SHM_V;
  float* ws = (float*)(lds + 2 * SHM_V + 2 * SHM_K) + wid * 64; float* li_l = ws; float* al_l = ws + 32;
  float m_reg = -1e30f, l_reg = 0; f32x16 o[4] = {}; bf16x8 qr[ND];
  {
    static_assert(QNORM, "attn_body: f32 partial q rows + per-head norm");
    const float* Qw = Qb + (long)(wid * QBLK + r32) * LDQ + hi * 8; constexpr long PST = (long)8192 * LDQ;
    f32x4 qa[ND][2]; float ss = 0.f;
#pragma unroll
    for (int d0 = 0; d0 < ND; ++d0) { qa[d0][0] = *(const f32x4*)(Qw + d0 * 16) + *(const f32x4*)(Qw + PST + d0 * 16); qa[d0][1] = *(const f32x4*)(Qw + d0 * 16 + 4) + *(const f32x4*)(Qw + PST + d0 * 16 + 4);
#pragma unroll
      for (int j = 0; j < 4; ++j) ss += qa[d0][0][j] * qa[d0][0][j] + qa[d0][1][j] * qa[d0][1][j]; }
    { auto rr = __builtin_amdgcn_permlane32_swap(__float_as_uint(ss), __float_as_uint(ss), false, false); ss = __uint_as_float(rr[0]) + __uint_as_float(rr[1]); }
    const float rstd = 1.0f / sqrtf(ss * (1.0f / 128.0f) + 1e-6f);
#pragma unroll
    for (int d0 = 0; d0 < ND; ++d0) { const f32x4 g0 = *(const f32x4*)(qg + d0 * 16 + hi * 8), g1 = *(const f32x4*)(qg + d0 * 16 + hi * 8 + 4);
      u32x4 y; y[0] = cvtpk(qa[d0][0][0] * rstd * g0[0], qa[d0][0][1] * rstd * g0[1]); y[1] = cvtpk(qa[d0][0][2] * rstd * g0[2], qa[d0][0][3] * rstd * g0[3]);
      y[2] = cvtpk(qa[d0][1][0] * rstd * g1[0], qa[d0][1][1] * rstd * g1[1]); y[3] = cvtpk(qa[d0][1][2] * rstd * g1[2], qa[d0][1][3] * rstd * g1[3]);
      qr[d0] = *reinterpret_cast<bf16x8*>(&y); }
  }
  const int sr = tid >> 4, sc = (tid & 15) * 8, vst0 = v_st(sr, sc), vst1 = v_st(32 + sr, sc);
  int krow[KCH], kcc[KCH];
#pragma unroll
  for (int i = 0; i < KCH; ++i) { const int c = tid + 512 * i; krow[i] = c / NKC; kcc[i] = c % NKC; }
  const int vb0 = (int)(uintptr_t)V_lds + v_rd_base(lane);
  struct { bf16x8 vs0, vs1, ks[KCH]; } sr_[SDEPTH];
#define SLOAD(i, k0) do { sr_[i].vs0 = *reinterpret_cast<const bf16x8*>(&Vh[(long)((k0) + sr) * LDK + sc]); sr_[i].vs1 = *reinterpret_cast<const bf16x8*>(&Vh[(long)((k0) + 32 + sr) * LDK + sc]); \
    _Pragma("unroll") for (int q_ = 0; q_ < KCH; ++q_) sr_[i].ks[q_] = *reinterpret_cast<const bf16x8*>(&Kh[(long)((k0) + krow[q_]) * LDK + kcc[q_] * 8]); } while (0)
#define SWRITE(b, i) do { *(bf16x8*)(V_lds + (b) * SHM_V + vst0) = sr_[i].vs0; *(bf16x8*)(V_lds + (b) * SHM_V + vst1) = sr_[i].vs1; \
    _Pragma("unroll") for (int q_ = 0; q_ < KCH; ++q_) *(bf16x8*)(K_lds + (b) * SHM_K + kswz<DQK>(krow[q_], kcc[q_] * 16)) = sr_[i].ks[q_]; } while (0)
#define SWAIT() do { if constexpr (SDEPTH == 2) asm volatile("s_waitcnt vmcnt(4)" ::: "memory"); else asm volatile("s_waitcnt vmcnt(0)" ::: "memory"); } while (0)
#define RESC(a) do { if (__any((a) < 1.f)) { if (hi == 0) al_l[r32] = (a); asm volatile("s_waitcnt lgkmcnt(0)" ::: "memory"); \
    _Pragma("unroll") for (int d = 0; d < 4; ++d) _Pragma("unroll") for (int r = 0; r < 16; ++r) o[d][r] *= al_l[crow(r, hi)]; } } while (0)
  f32x16 pA0, pA1, pB0, pB1; float mnA, mnB, alA, alB; bf16x8 pa0, pa1, pa2, pa3; const int NT = seq / KVBLK;
  const int qrel = wid * QBLK + r32;
#define CMASK(P0, P1, t) do { if constexpr (CAUSAL) { const int jb_ = (t) - (NT - 4); if (jb_ >= 0) cmask(P0, P1, jb_, qrel, hi); } } while (0)
  constexpr int SE = 0, SO = SDEPTH - 1;
  SLOAD(SE, 0); asm volatile("s_waitcnt vmcnt(0)" ::: "memory"); SWRITE(0, SE); __syncthreads();
  qkt<DQK>(pA0, pA1, K_lds, qr, r32, hi); CMASK(pA0, pA1, 0); partialSM<SC>(pA0, pA1, m_reg, mnA, alA);
  SLOAD(SO, KVBLK); if constexpr (SDEPTH == 2) { if (2 < NT) SLOAD(SE, 2 * KVBLK); }
  SWAIT(); SWRITE(1, SO); __syncthreads();
  for (int j = 1; j + 1 < NT; j += 2) {
    SBAR(); qkt<DQK>(pB0, pB1, K_lds + SHM_K, qr, r32, hi); CMASK(pB0, pB1, j);
    finishSM(pA0, pA1, alA, l_reg, pa0, pa1, pa2, pa3); SBAR();
    SLOAD(SO, (j + SDEPTH) * KVBLK); SBAR();
    pv_d0(o, vb0, pa0, pa1, pa2, pa3); partialSM<SC>(pB0, pB1, m_reg, mnB, alB);
    __syncthreads(); SWAIT(); SWRITE(0, SE);
    RESC(alB); __syncthreads();
    SBAR(); qkt<DQK>(pA0, pA1, K_lds, qr, r32, hi); CMASK(pA0, pA1, j + 1);
    finishSM(pB0, pB1, alB, l_reg, pa0, pa1, pa2, pa3); SBAR();
    if (SDEPTH == 1 || j + 3 < NT) SLOAD(SE, (j + 1 + SDEPTH) * KVBLK); SBAR();
    pv_d0(o, vb0 + SHM_V, pa0, pa1, pa2, pa3); partialSM<SC>(pA0, pA1, m_reg, mnA, alA);
    __syncthreads(); SWAIT(); SWRITE(1, SO);
    RESC(alA); __syncthreads();
  }
  SBAR(); qkt<DQK>(pB0, pB1, K_lds + SHM_K, qr, r32, hi); CMASK(pB0, pB1, NT - 1);
  finishSM(pA0, pA1, alA, l_reg, pa0, pa1, pa2, pa3); SBAR();
  pv_d0(o, vb0, pa0, pa1, pa2, pa3); partialSM<SC>(pB0, pB1, m_reg, mnB, alB);
  __syncthreads(); RESC(alB);
  finishSM(pB0, pB1, alB, l_reg, pa0, pa1, pa2, pa3); SBAR();
  pv_d0(o, vb0 + SHM_V, pa0, pa1, pa2, pa3);
  if (hi == 0) li_l[r32] = l_reg; asm volatile("s_waitcnt lgkmcnt(0)" ::: "memory");
  float rli[16];
#pragma unroll
  for (int r = 0; r < 16; ++r) rli[r] = __builtin_amdgcn_rcpf(li_l[crow(r, hi)]);
  bf16* Ow = Ob + (long)(wid * QBLK) * LDO;
#pragma unroll
  for (int r = 0; r < 16; ++r) { const int orow = crow(r, hi); float ssr = 0.f;
#pragma unroll
    for (int d0 = 0; d0 < 4; ++d0) { const float v = o[d0][r] * rli[r]; ssr += v * v; Ow[(long)orow * LDO + d0 * 32 + r32] = (bf16)(cvtpk(v, 0.f) & 0xffffu); }
    if constexpr (ROWSQ) {
      ssr += __shfl_xor(ssr, 1); ssr += __shfl_xor(ssr, 2); ssr += __shfl_xor(ssr, 4); ssr += __shfl_xor(ssr, 8); ssr += __shfl_xor(ssr, 16);
      if (r32 == 0) pg8::atomic_addf(rs + wid * QBLK + orow, ssr);
    } }
  __syncthreads();
#undef SLOAD
#undef SWRITE
#undef SWAIT
#undef RESC
#undef CMASK
}

template <int DQK, int LDQ, int LDK, bool CAUSAL, class SC>
__device__ __forceinline__ void attn_body_s(const bf16* __restrict__ Qb, const bf16* __restrict__ Kh, const bf16* __restrict__ Vh, bf16* __restrict__ Ob, int ldo, int seq, int t_begin, int t_end, float* ml, int ml_stride, const int wave_, char* lds) {
  constexpr int ND = DQK / 16, NKC = DQK / 8, KCH = (64 * NKC) / 512;
  constexpr int SHM_V = KVBLK * 128 * 2, SHM_K = KVBLK * (DQK == 128 ? 256 : DQK * 2 + 16);
  int tid = wave_ * 64 + lane_id(); asm volatile("" : "+v"(tid));
  const int wid = wave_, lane = tid & 63, r32 = lane & 31, hi = lane >> 5;
  char* V_lds = lds; char* K_lds = lds + 2 * SHM_V;
  float* ws = (float*)(lds + 2 * SHM_V + 2 * SHM_K) + wid * 64; float* li_l = ws; float* al_l = ws + 32;
  constexpr int NDR = ND > 8 ? 8 : ND;
  char* Qs = lds + 2 * SHM_V + 2 * SHM_K + 2048 + wid * ((ND - NDR) * 1024) + lane * 16;
  float m_reg = -1e30f, l_reg = 0; f32x16 o[4] = {}; bf16x8 qr[NDR];
  const bf16* Qw = Qb + (long)(wid * QBLK + r32) * LDQ + hi * 8;
#pragma unroll
  for (int d0 = 0; d0 < NDR; ++d0) qr[d0] = *reinterpret_cast<const bf16x8*>(Qw + d0 * 16);
#pragma unroll
  for (int d0 = NDR; d0 < ND; ++d0) *(bf16x8*)(Qs + (d0 - NDR) * 1024) = *reinterpret_cast<const bf16x8*>(Qw + d0 * 16);
  const int sr = tid >> 4, sc = (tid & 15) * 8, vst0 = v_st(sr, sc), vst1 = v_st(32 + sr, sc);
  int krow[KCH], kcc[KCH];
#pragma unroll
  for (int i = 0; i < KCH; ++i) { const int c = tid + 512 * i; krow[i] = c / NKC; kcc[i] = c % NKC; }
  const int vb0 = (int)(uintptr_t)V_lds + v_rd_base(lane);
  bf16x8 vs0, vs1, ks[KCH];
  unsigned koff[KCH]; const unsigned voff0 = (unsigned)(sr * LDK + sc) * 2u, voff1 = (unsigned)((32 + sr) * LDK + sc) * 2u;
#pragma unroll
  for (int i = 0; i < KCH; ++i) koff[i] = (unsigned)(krow[i] * LDK + kcc[i] * 8) * 2u;
#define SLOAD(k0) do { const char* Kt_ = (const char*)Kh + (size_t)(k0) * (LDK * 2); const char* Vt_ = (const char*)Vh + (size_t)(k0) * (LDK * 2); \
    vs0 = *reinterpret_cast<const bf16x8*>(Vt_ + voff0); vs1 = *reinterpret_cast<const bf16x8*>(Vt_ + voff1); \
    _Pragma("unroll") for (int q_ = 0; q_ < KCH; ++q_) ks[q_] = *reinterpret_cast<const bf16x8*>(Kt_ + koff[q_]); } while (0)
#define SWRITE(b) do { *(bf16x8*)(V_lds + (b) * SHM_V + vst0) = vs0; *(bf16x8*)(V_lds + (b) * SHM_V + vst1) = vs1; \
    _Pragma("unroll") for (int q_ = 0; q_ < KCH; ++q_) *(bf16x8*)(K_lds + (b) * SHM_K + kswz<DQK>(krow[q_], kcc[q_] * 16)) = ks[q_]; } while (0)
  const int NT = seq / KVBLK; const int qrel = wid * QBLK + r32;
  SLOAD(t_begin * KVBLK); asm volatile("s_waitcnt vmcnt(0)" ::: "memory"); SWRITE(0); __syncthreads();
  for (int j = t_begin; j < t_end; ++j) {
    const int bsel = (j - t_begin) & 1;
    if (j + 1 < t_end) SLOAD((j + 1) * KVBLK);
    f32x16 p0, p1; float mn, al; bf16x8 pa0, pa1, pa2, pa3;
    SBAR();
    { const char* Ks = K_lds + bsel * SHM_K; p0 = f32x16{}; p1 = f32x16{};
#pragma unroll
      for (int d0 = 0; d0 < ND; ++d0) { const int cb = (d0 * 16 + hi * 8) * 2;
        const bf16x8 b0 = *reinterpret_cast<const bf16x8*>(Ks + kswz<DQK>(r32, cb)), b1 = *reinterpret_cast<const bf16x8*>(Ks + kswz<DQK>(32 + r32, cb));
        bf16x8 qf; if (d0 < NDR) qf = qr[d0 < NDR ? d0 : 0]; else qf = *(const bf16x8*)(Qs + (d0 - NDR) * 1024);
        p0 = __builtin_amdgcn_mfma_f32_32x32x16_bf16(b0, qf, p0, 0, 0, 0);
        p1 = __builtin_amdgcn_mfma_f32_32x32x16_bf16(b1, qf, p1, 0, 0, 0); } }
    if constexpr (CAUSAL) { const int jb_ = j - (NT - 4); if (jb_ >= 0) cmask(p0, p1, jb_, qrel, hi); }
    partialSM<SC>(p0, p1, m_reg, mn, al);
    if (__any(al < 1.f)) { if (hi == 0) al_l[r32] = al; asm volatile("s_waitcnt lgkmcnt(0)" ::: "memory");
#pragma unroll
      for (int d = 0; d < 4; ++d)
#pragma unroll
        for (int r = 0; r < 16; ++r) o[d][r] *= al_l[crow(r, hi)]; }
    finishSM(p0, p1, al, l_reg, pa0, pa1, pa2, pa3); SBAR();
    pv_d0(o, vb0 + bsel * SHM_V, pa0, pa1, pa2, pa3);
    if (j + 1 < t_end) { asm volatile("s_waitcnt vmcnt(0)" ::: "memory"); SWRITE(bsel ^ 1); }
    __syncthreads();
  }
  if (hi == 0) { li_l[r32] = l_reg; ml[(long)(wid * QBLK + r32) * ml_stride] = m_reg; ml[(long)(wid * QBLK + r32) * ml_stride + 1] = l_reg; }
  asm volatile("s_waitcnt lgkmcnt(0)" ::: "memory");
  float rli[16];
#pragma unroll
  for (int r = 0; r < 16; ++r) { const float lv = li_l[crow(r, hi)]; rli[r] = lv > 0.f ? __builtin_amdgcn_rcpf(lv) : 0.f; }
  bf16* Ow = Ob + (long)(wid * QBLK) * ldo;
#pragma unroll
  for (int r = 0; r < 16; ++r) { const int orow = crow(r, hi);
#pragma unroll
    for (int d0 = 0; d0 < 4; ++d0) Ow[(long)orow * ldo + d0 * 32 + r32] = (bf16)(cvtpk(o[d0][r] * rli[r], 0.f) & 0xffffu); }
  __syncthreads();
#undef SLOAD
#undef SWRITE
}
template <int DQK, int LDQ, int LDK, bool CAUSAL, class SC>
__device__ __forceinline__ void attn_body_p(const bf16* __restrict__ Qb, const bf16* __restrict__ Kh, const bf16* __restrict__ Vh, bf16* __restrict__ Ob, int ldo, int seq, int t_begin, int t_end, float* ml, int ml_stride, const int wave_, char* lds) {
  constexpr int ND = DQK / 16, NKC = DQK / 8, KCH = (64 * NKC) / 512, NDR = ND > 8 ? 8 : ND;
  constexpr int SHM_V = KVBLK * 128 * 2, SHM_K = KVBLK * (DQK == 128 ? 256 : DQK * 2 + 16);
  int tid = wave_ * 64 + lane_id(); asm volatile("" : "+v"(tid));
  const int wid = wave_, lane = tid & 63, r32 = lane & 31, hi = lane >> 5;
  char* V_lds = lds; char* K_lds = lds + 2 * SHM_V;
  float* ws = (float*)(lds + 2 * SHM_V + 2 * SHM_K) + wid * 64; float* li_l = ws; float* al_l = ws + 32;
  char* Qs = lds + 2 * SHM_V + 2 * SHM_K + 2048 + wid * ((ND - NDR) * 1024) + lane * 16;
  float m_reg = -1e30f, l_reg = 0; f32x16 o[4] = {}; bf16x8 qr[NDR];
  const bf16* Qw = Qb + (long)(wid * QBLK + r32) * LDQ + hi * 8;
#pragma unroll
  for (int d0 = 0; d0 < NDR; ++d0) qr[d0] = *reinterpret_cast<const bf16x8*>(Qw + d0 * 16);
#pragma unroll
  for (int d0 = NDR; d0 < ND; ++d0) *(bf16x8*)(Qs + (d0 - NDR) * 1024) = *reinterpret_cast<const bf16x8*>(Qw + d0 * 16);
  const int sr = tid >> 4, sc = (tid & 15) * 8, vst0 = v_st(sr, sc), vst1 = v_st(32 + sr, sc);
  unsigned koff[KCH]; int kdst[KCH]; const unsigned voff0 = (unsigned)(sr * LDK + sc) * 2u, voff1 = (unsigned)((32 + sr) * LDK + sc) * 2u;
#pragma unroll
  for (int i = 0; i < KCH; ++i) { const int c = tid + 512 * i, kr = c / NKC, kc = c % NKC; koff[i] = (unsigned)(kr * LDK + kc * 8) * 2u; kdst[i] = kswz<DQK>(kr, kc * 16); }
  const int vb0 = (int)(uintptr_t)V_lds + v_rd_base(lane);
  bf16x8 vs0, vs1, ks[KCH];
#define SLOAD(k0) do { const char* Kt_ = (const char*)Kh + (size_t)(k0) * (LDK * 2); const char* Vt_ = (const char*)Vh + (size_t)(k0) * (LDK * 2); \
    vs0 = *reinterpret_cast<const bf16x8*>(Vt_ + voff0); vs1 = *reinterpret_cast<const bf16x8*>(Vt_ + voff1); \
    _Pragma("unroll") for (int q_ = 0; q_ < KCH; ++q_) ks[q_] = *reinterpret_cast<const bf16x8*>(Kt_ + koff[q_]); } while (0)
#define SWRITE(b) do { *(bf16x8*)(V_lds + (b) * SHM_V + vst0) = vs0; *(bf16x8*)(V_lds + (b) * SHM_V + vst1) = vs1; \
    _Pragma("unroll") for (int q_ = 0; q_ < KCH; ++q_) *(bf16x8*)(K_lds + (b) * SHM_K + kdst[q_]) = ks[q_]; } while (0)
#define QKT(P0, P1, Ks_) do { const char* Ksb = (Ks_); P0 = f32x16{}; P1 = f32x16{}; \
    _Pragma("unroll") for (int d0 = 0; d0 < ND; ++d0) { const int cb = (d0 * 16 + hi * 8) * 2; \
      const bf16x8 b0 = *reinterpret_cast<const bf16x8*>(Ksb + kswz<DQK>(r32, cb)), b1 = *reinterpret_cast<const bf16x8*>(Ksb + kswz<DQK>(32 + r32, cb)); \
      bf16x8 qf; if (d0 < NDR) qf = qr[d0 < NDR ? d0 : 0]; else qf = *(const bf16x8*)(Qs + (d0 - NDR) * 1024); \
      P0 = __builtin_amdgcn_mfma_f32_32x32x16_bf16(b0, qf, P0, 0, 0, 0); P1 = __builtin_amdgcn_mfma_f32_32x32x16_bf16(b1, qf, P1, 0, 0, 0); } } while (0)
#define RESC(a) do { if (__any((a) < 1.f)) { if (hi == 0) al_l[r32] = (a); asm volatile("s_waitcnt lgkmcnt(0)" ::: "memory"); \
    _Pragma("unroll") for (int d = 0; d < 4; ++d) _Pragma("unroll") for (int r = 0; r < 16; ++r) o[d][r] *= al_l[crow(r, hi)]; } } while (0)
  f32x16 pA0, pA1, pB0, pB1; float mnA, mnB, alA, alB; bf16x8 pa0, pa1, pa2, pa3; const int NT = seq / KVBLK, n = t_end - t_begin;
  const int qrel = wid * QBLK + r32;
#define CMASK(P0, P1, t) do { if constexpr (CAUSAL) { const int jb_ = (t) - (NT - 4); if (jb_ >= 0) cmask(P0, P1, jb_, qrel, hi); } } while (0)
  SLOAD(t_begin * KVBLK); asm volatile("s_waitcnt vmcnt(0)" ::: "memory"); SWRITE(0); __syncthreads();
  QKT(pA0, pA1, K_lds); CMASK(pA0, pA1, t_begin); partialSM<SC>(pA0, pA1, m_reg, mnA, alA);
  SLOAD((t_begin + 1) * KVBLK);
  asm volatile("s_waitcnt vmcnt(0)" ::: "memory"); SWRITE(1); __syncthreads();
  for (int j = 1; j + 1 < n; j += 2) {
    SBAR(); QKT(pB0, pB1, K_lds + SHM_K); CMASK(pB0, pB1, t_begin + j);
    finishSM(pA0, pA1, alA, l_reg, pa0, pa1, pa2, pa3); SBAR();
    SLOAD((t_begin + j + 1) * KVBLK); SBAR();
    pv_d0(o, vb0, pa0, pa1, pa2, pa3); partialSM<SC>(pB0, pB1, m_reg, mnB, alB);
    __syncthreads(); asm volatile("s_waitcnt vmcnt(0)" ::: "memory"); SWRITE(0);
    RESC(alB); __syncthreads();
    SBAR(); QKT(pA0, pA1, K_lds); CMASK(pA0, pA1, t_begin + j + 1);
    finishSM(pB0, pB1, alB, l_reg, pa0, pa1, pa2, pa3); SBAR();
    SLOAD((t_begin + j + 2) * KVBLK); SBAR();
    pv_d0(o, vb0 + SHM_V, pa0, pa1, pa2, pa3); partialSM<SC>(pA0, pA1, m_reg, mnA, alA);
    __syncthreads(); asm volatile("s_waitcnt vmcnt(0)" ::: "memory"); SWRITE(1);
    RESC(alA); __syncthreads();
  }
  SBAR(); QKT(pB0, pB1, K_lds + SHM_K); CMASK(pB0, pB1, t_end - 1);
  finishSM(pA0, pA1, alA, l_reg, pa0, pa1, pa2, pa3); SBAR();
  pv_d0(o, vb0, pa0, pa1, pa2, pa3); partialSM<SC>(pB0, pB1, m_reg, mnB, alB);
  __syncthreads(); RESC(alB);
  finishSM(pB0, pB1, alB, l_reg, pa0, pa1, pa2, pa3); SBAR();
  pv_d0(o, vb0 + SHM_V, pa0, pa1, pa2, pa3);
  if (hi == 0) { li_l[r32] = l_reg; ml[(long)(wid * QBLK + r32) * ml_stride] = m_reg; ml[(long)(wid * QBLK + r32) * ml_stride + 1] = l_reg; }
  asm volatile("s_waitcnt lgkmcnt(0)" ::: "memory");
  float rli[16];
#pragma unroll
  for (int r = 0; r < 16; ++r) { const float lv = li_l[crow(r, hi)]; rli[r] = lv > 0.f ? __builtin_amdgcn_rcpf(lv) : 0.f; }
  bf16* Ow = Ob + (long)(wid * QBLK) * ldo;
#pragma unroll
  for (int r = 0; r < 16; ++r) { const int orow = crow(r, hi);
#pragma unroll
    for (int d0 = 0; d0 < 4; ++d0) Ow[(long)orow * ldo + d0 * 32 + r32] = (bf16)(cvtpk(o[d0][r] * rli[r], 0.f) & 0xffffu); }
  __syncthreads();
#undef SLOAD
#undef SWRITE
#undef QKT
#undef RESC
#undef CMASK
}
}

#define GAS __attribute__((address_space(1)))
#define LAS __attribute__((address_space(3)))
typedef unsigned short bf16;
typedef unsigned v4u __attribute__((ext_vector_type(4)));
typedef float f32x4 __attribute__((ext_vector_type(4)));
typedef short bf16x8 __attribute__((ext_vector_type(8)));
typedef GAS unsigned gu32;
typedef GAS unsigned long long gu64;
#define RLX_AGENT __ATOMIC_RELAXED, __HIP_MEMORY_SCOPE_AGENT
#define LDS_WAIT() asm volatile("s_waitcnt lgkmcnt(0)" ::: "memory")
#define VM_WAIT() asm volatile("s_waitcnt vmcnt(0)" ::: "memory")
__device__ __forceinline__ unsigned long long rt() { return __builtin_amdgcn_s_memrealtime(); }
__device__ __forceinline__ unsigned f2bf(float f) { unsigned u = __builtin_bit_cast(unsigned, f); return (u + 0x7fffu + ((u >> 16) & 1u)) >> 16; }
__device__ __forceinline__ unsigned pk2(float lo, float hi) { return f2bf(lo) | (f2bf(hi) << 16); }

#define XB_TMO      128
#define XB_XCNT(j)  (256  + 64 * (j))
#define XB_XSUB(j)  (1280 + 64 * (j))
#define XB_XGEN(j)  (2304 + 64 * (j))
#define XB_TOP      3328
#define XB_TOPGEN   3392
#define XCD_BAR_WORDS 3456
#define XB_SPIN_CAP (1u << 18)

__device__ __forceinline__ unsigned xb_ld(unsigned* p)              { return __hip_atomic_load(p, __ATOMIC_RELAXED, __HIP_MEMORY_SCOPE_AGENT); }
__device__ __forceinline__ unsigned xb_add(unsigned* p, unsigned v) { return __hip_atomic_fetch_add(p, v, __ATOMIC_RELAXED, __HIP_MEMORY_SCOPE_AGENT); }
__device__ __forceinline__ unsigned xb_xcc_id() { return (unsigned)__builtin_amdgcn_s_getreg((3 << 11) | 20) & 0xFu; }
#define XB_SPIN(cond, bar) do { unsigned _sp = 0; while (cond) { __builtin_amdgcn_s_sleep(1); \
    if ((++_sp & 255u) == 0u) { if (xb_ld(&(bar)[XB_TMO])) break; if (_sp > XB_SPIN_CAP) { atomicAdd(&(bar)[XB_TMO], 1u); break; } } } } while (0)

struct XcdBarrier {
    unsigned* bar; unsigned x;
    volatile LAS unsigned* st;
};

__device__ __forceinline__ XcdBarrier xcd_barrier_post(unsigned* bar, volatile LAS unsigned* st, const int wave_) {
    XcdBarrier b; b.bar = bar; b.x = xb_xcc_id(); b.st = st;
    if (wave_ == 0 && lane_id() == 0) (void)xb_add(&bar[XB_XCNT(b.x)], 1u);
    return b;
}
__device__ __forceinline__ void xcd_barrier_complete(unsigned* bar, unsigned x, unsigned& nloc, unsigned& nx) {
    const unsigned G = gridDim.x * gridDim.y * gridDim.z;
    unsigned sum, cnt, mine, sp = 0u;
    for (;;) {
        sum = 0u; cnt = 0u; mine = 0u;
#pragma unroll
        for (unsigned j = 0; j < 16; ++j) { const unsigned c = xb_ld(&bar[XB_XCNT(j)]); sum += c; cnt += (c > 0u) ? 1u : 0u; mine = (j == x) ? c : mine; }
        if (sum == G) break;
        __builtin_amdgcn_s_sleep(1);
        if ((++sp & 255u) == 0u) { if (xb_ld(&bar[XB_TMO])) break; if (sp > XB_SPIN_CAP) { atomicAdd(&bar[XB_TMO], 1u); break; } }
    }
    nloc = mine > 0u ? mine : 1u; nx = cnt > 0u ? cnt : 1u;
}

__device__ __forceinline__ void xcd_barrier(const XcdBarrier& b, const int wave_) {
    asm volatile("s_waitcnt vmcnt(0)" ::: "memory");
    __syncthreads();
    if (wave_ == 0 && lane_id() == 0) {
        unsigned* bar = b.bar;
        __builtin_amdgcn_s_waitcnt(0);
        unsigned nloc = b.st[0], nx = b.st[1];
        if (nloc == 0u) { xcd_barrier_complete(bar, b.x, nloc, nx); b.st[0] = nloc; b.st[1] = nx; }
        const unsigned old = xb_add(&bar[XB_XSUB(b.x)], 1u);
        const unsigned gen = old / nloc;
        if (old + 1u == (gen + 1u) * nloc) {
            __builtin_amdgcn_fence(__ATOMIC_RELEASE, "agent");
            asm volatile("s_waitcnt vmcnt(0)" ::: "memory");
            const unsigned og = xb_add(&bar[XB_TOP], 1u);
            const unsigned tg = og / nx;
            if (og + 1u == (tg + 1u) * nx) xb_add(&bar[XB_TOPGEN], 1u);
            else XB_SPIN(xb_ld(&bar[XB_TOPGEN]) == tg, bar);
            __builtin_amdgcn_fence(__ATOMIC_ACQUIRE, "agent");
            xb_add(&bar[XB_XGEN(b.x)], 1u);
            asm volatile("s_waitcnt vmcnt(0)" ::: "memory");
        } else {
            XB_SPIN(xb_ld(&bar[XB_XGEN(b.x)]) == gen, bar);
            __builtin_amdgcn_fence(__ATOMIC_ACQUIRE, "agent");
            asm volatile("s_waitcnt vmcnt(0)" ::: "memory");
        }
    }
    __syncthreads();
}

enum Phase { PH_PREP_FFN1 = 0, PH_FFN1_GU, PH_FFN1_DOWN, PH_WIN, PH_UP, PH_FINAL_QK, PH_FINAL_XK, PH_HG_B, PH_ATTN, PH_COMBINE,
             PH_WOUT, PH_XQ, PH_XATTN, PH_XO, PH_FFN2_GU, PH_FFN2_DOWN, PH_COUNT };
constexpr int FFN2_SPLIT = 3600;
#ifndef MK_CMASK
#define MK_CMASK 0xffffffffu
#endif
constexpr unsigned NOBAR_AFTER = (1u << PH_FINAL_QK) | (1u << PH_FINAL_XK);

struct Frame {
    LAS unsigned char* lds; char* ldsg;
    int wave, vcu, G;
    const float* in[30]; float* out; unsigned char* ws;
};
__device__ __forceinline__ float wave_sum(float v) {
#pragma unroll
    for (int o = 1; o < 64; o <<= 1) v += __shfl_xor(v, o);
    return v;
}
__device__ __forceinline__ float bf2f(bf16 b) { return __uint_as_float((unsigned)b << 16); }

template <int MAP> __device__ __forceinline__ int map_row(int n0) {
    if (MAP == 1) return (n0 >> 7) * 256 + (n0 & 127);
    if (MAP == 2) return (n0 >> 7) * 256 + 128 + (n0 & 127);
    if (MAP == 3) return n0 < 832 ? n0 : n0 + 192;
    if (MAP == 4) { const int h = n0 >> 8, j = n0 & 255; return h * 320 + (j < 128 ? j : j + 64); }
    return n0;
}
template <int MAP, bool NTS = false> __device__ __forceinline__ void tr_item(const float* W, int K, int N, const float* gain, int gainK, bf16* WT, LAS float* scr, int item, int lane) {
    const int nblk = N / 64, kb = item / nblk, nb = item % nblk, k0 = 64 * kb, n0 = 64 * nb, c4 = (lane & 15) * 4, kq = lane >> 4;
    f32x4 v[16];
#pragma unroll
    for (int i = 0; i < 16; ++i) v[i] = __builtin_nontemporal_load((const GAS f32x4*)(W + (size_t)(k0 + 4 * i + kq) * N + n0 + c4));
#pragma unroll
    for (int i = 0; i < 16; ++i) { const int kk = 4 * i + kq; const float g = (gain != nullptr && k0 + kk < gainK) ? gain[k0 + kk] : 1.0f;
        *(LAS f32x4*)(scr + kk * 64 + (c4 ^ (((kk >> 3) & 7) << 2))) = v[i] * g; }
    LDS_WAIT(); asm volatile("" ::: "memory");
    const int c = lane & 7, dr0 = map_row<MAP>(n0);
#pragma unroll
    for (int j = 0; j < 8; ++j) { const int n = (lane >> 3) + 8 * j; const LAS float* s = scr + (8 * c) * 64 + (n ^ (c << 2));
        v4u o; o.x = cvtpk(s[0 * 64], s[1 * 64]); o.y = cvtpk(s[2 * 64], s[3 * 64]); o.z = cvtpk(s[4 * 64], s[5 * 64]); o.w = cvtpk(s[6 * 64], s[7 * 64]);
        if (NTS) __builtin_nontemporal_store(o, (GAS v4u*)(WT + (size_t)(dr0 + n) * K + k0 + 8 * c)); else *(GAS v4u*)(WT + (size_t)(dr0 + n) * K + k0 + 8 * c) = o; }
    LDS_WAIT(); asm volatile("" ::: "memory");
}
__device__ __forceinline__ void norm_row_bf16(const float* xrow, const float* g, bf16* orow, int lane) {
    const GAS f32x4* xr = (const GAS f32x4*)xrow + lane; const GAS f32x4* gr = (const GAS f32x4*)g + lane;
    f32x4 v[8]; float s = 0.f;
#pragma unroll
    for (int j = 0; j < 8; ++j) { v[j] = __builtin_nontemporal_load(xr + 64 * j); s += pg8::dot4(v[j]); }
    const float rstd = 1.0f / sqrtf(wave_sum(s) * (1.0f / DM) + EPS);
    GAS unsigned long long* o8 = (GAS unsigned long long*)orow + lane;
#pragma unroll
    for (int j = 0; j < 8; ++j) { const f32x4 gg = gr[64 * j]; o8[64 * j] = (unsigned long long)cvtpk(v[j].x * rstd * gg.x, v[j].y * rstd * gg.y) | ((unsigned long long)cvtpk(v[j].z * rstd * gg.z, v[j].w * rstd * gg.w) << 32); }
}
#define GW_LOOP(var, n) for (int var = gw; var < (n); var += NGW)
constexpr int I_FFN_G = (DM / 64) * (DFF / 64), I_FFN_D = (DFF / 64) * (DM / 64);
__device__ __forceinline__ void ph_prep_ffn1(Frame& F) {
    LAS float* scr = (LAS float*)(F.lds + F.wave * 16384);
    const int gw = F.vcu * NWAVES + F.wave, NGW = F.G * NWAVES;
    bf16* WGU = (bf16*)(F.ws + WS_WGU);
    GW_LOOP(it, 2 * I_FFN_G) { if (it < I_FFN_G) tr_item<1>(F.in[4], DM, DFF, nullptr, 0, WGU, scr, it, lane_id()); else tr_item<2>(F.in[5], DM, DFF, nullptr, 0, WGU, scr, it - I_FFN_G, lane_id()); }
    bf16* XB = (bf16*)(F.ws + WS_XB); GW_LOOP(m, M) norm_row_bf16(F.in[0] + (size_t)m * DM, F.in[3], XB + (size_t)m * DM, lane_id());
}
__device__ __forceinline__ void tail_job_a(Frame& F, int worker, int nworkers) {
    LAS float* scr = (LAS float*)(F.lds + F.wave * 16384);
    const int gw = worker * NWAVES + F.wave, NGW = nworkers * NWAVES;
    bf16* WD = (bf16*)(F.ws + WS_WD); bf16* WIN = (bf16*)(F.ws + WS_WIN); bf16* WQUP = (bf16*)(F.ws + WS_WQUP); bf16* WKVUP = (bf16*)(F.ws + WS_WKVUP); bf16* WOUT = (bf16*)(F.ws + WS_WOUT);
    bf16* WXQ = (bf16*)(F.ws + WS_WXQ); bf16* WXKV = (bf16*)(F.ws + WS_WXKV); bf16* WXO = (bf16*)(F.ws + WS_WXO);
    constexpr int I_IN = (DM / 64) * (INC / 64), I_Q = (512 / 64) * (1536 / 64), I_KV = (256 / 64) * (2048 / 64), I_O = (DM / 64) * (DM / 64);
    constexpr int I_XQ = (DM / 64) * (512 / 64), I_XKV = (DM / 64) * (1024 / 64), I_XO = (512 / 64) * (DM / 64);
    GW_LOOP(it, I_FFN_D + I_IN + I_Q + I_KV + I_O + I_XQ + I_XKV + I_XO) {
        int r = it;
        if (r < I_XQ) { tr_item<0, true>(F.in[21], DM, 512, F.in[19], DM, WXQ, scr, r, lane_id()); continue; } r -= I_XQ;
        if (r < I_XO) { tr_item<0, true>(F.in[25], 512, DM, nullptr, 0, WXO, scr, r, lane_id()); continue; } r -= I_XO;
        if (r < I_O) { tr_item<0>(F.in[18], DM, DM, F.in[15], 1024, WOUT, scr, r, lane_id()); continue; } r -= I_O;
        if (r < I_XKV) { tr_item<0>(F.in[22], DM, 1024, nullptr, 0, WXKV, scr, r, lane_id()); continue; } r -= I_XKV;
        if (r < I_Q) { tr_item<0>(F.in[10], 512, 1536, F.in[9], 512, WQUP, scr, r, lane_id()); continue; } r -= I_Q;
        if (r < I_KV) { tr_item<4>(F.in[12], 256, 2048, F.in[11], 256, WKVUP, scr, r, lane_id()); continue; } r -= I_KV;
        if (r < I_IN) { tr_item<3>(F.in[8], DM, INC, F.in[7], DM, WIN, scr, r, lane_id()); continue; } r -= I_IN;
        tr_item<0>(F.in[6], DFF, DM, nullptr, 0, WD, scr, r, lane_id());
    }
    const int gt = gw * 64 + lane_id(), NGT = NGW * 64;
    for (int i = gt; i < 192 * 256; i += NGT) *(GAS v4u*)(WIN + (size_t)832 * DM + (size_t)i * 8) = (v4u){0u, 0u, 0u, 0u};
    for (int i = gt; i < 8 * 64 * 32; i += NGT) { const int h = i >> 11, rr = (i >> 5) & 63, c = i & 31; *(GAS v4u*)(WKVUP + (size_t)(h * 320 + 128 + rr) * 256 + c * 8) = (v4u){0u, 0u, 0u, 0u}; }
    float* LB = (float*)(F.ws + WS_LB); float* ROPE = (float*)(F.ws + WS_ROPE);
    for (int i = gt; i < 1024; i += NGT) { const float l0 = F.in[16][i], l1 = F.in[16][1024 + i]; const float mx = fmaxf(l0, l1); const float e0 = expf(l0 - mx), e1 = expf(l1 - mx); LB[i] = e0 / (e0 + e1); }
    const int* pos = (const int*)F.in[2];
    for (int i = gt; i < M * 32; i += NGT) { const int row = i >> 5, fq = i & 31; const float inv_freq = powf(10000.0f, -(float)fq / 32.0f); const float ang = (float)pos[row] * inv_freq;
        ROPE[(size_t)row * 64 + fq] = cosf(ang); ROPE[(size_t)row * 64 + 32 + fq] = sinf(ang); }
    bf16* MEMN = (bf16*)(F.ws + WS_MEMN);
    GW_LOOP(m, MMEM) norm_row_bf16(F.in[1] + (size_t)m * DM, F.in[20], MEMN + (size_t)m * DM, lane_id());
}
__device__ __forceinline__ void tail_job_ffn2(Frame& F, int worker, int nworkers, int lo, int hi) {
    LAS float* scr = (LAS float*)(F.lds + F.wave * 16384);
    const int gw = worker * NWAVES + F.wave, NGW = nworkers * NWAVES;
    bf16* WGU = (bf16*)(F.ws + WS_W2GU); bf16* WD = (bf16*)(F.ws + WS_W2D);
    for (int it = lo + gw; it < hi; it += NGW) {
        if (it < I_FFN_G) tr_item<1, true>(F.in[27], DM, DFF, F.in[26], DM, WGU, scr, it, lane_id());
        else if (it < 2 * I_FFN_G) tr_item<2, true>(F.in[28], DM, DFF, F.in[26], DM, WGU, scr, it - I_FFN_G, lane_id());
        else tr_item<0, true>(F.in[29], DFF, DM, nullptr, 0, WD, scr, it - 2 * I_FFN_G, lane_id());
    }
}
__device__ __forceinline__ bool light_worker(int nwg, int G, int c, int& worker, int& nworkers) {
    const int rounds = (nwg + G - 1) / G, rem = nwg - (rounds - 1) * G;
    if (rem >= G) { worker = c; nworkers = G; return true; }
    worker = c - rem; nworkers = G - rem; return c >= rem;
}

__device__ __forceinline__ void ph_final_qk(Frame& F) {
    const int gw = F.vcu * NWAVES + F.wave, NGW = F.G * NWAVES, lane = lane_id(), h = lane >> 3, s = lane & 7;
    bf16* QRAW = (bf16*)(F.ws + WS_QRAW); bf16* KV = (bf16*)(F.ws + WS_KV); const float* KPE = (const float*)(F.ws + WS_KPE); const float* ROPE = (const float*)(F.ws + WS_ROPE);
    const float* qn = F.in[13]; const float* kn = F.in[14];
    f32x4 gq[6], gk[6];
#pragma unroll
    for (int j = 0; j < 3; ++j) { gq[2 * j] = *(const f32x4*)(qn + 64 * j + 8 * s); gq[2 * j + 1] = *(const f32x4*)(qn + 64 * j + 8 * s + 4);
                                  gk[2 * j] = *(const f32x4*)(kn + 64 * j + 8 * s); gk[2 * j + 1] = *(const f32x4*)(kn + 64 * j + 8 * s + 4); }
    const float sgn = (s < 4) ? -1.0f : 1.0f;
    for (int row0 = gw; row0 < M; row0 += 2 * NGW) {
        v4u qw[2][3], kw[2][2]; f32x4 kp0[2], kp1[2], c0[2], c1[2], s0[2], s1[2]; int rowv[2]; bool ok[2];
#pragma unroll
        for (int q = 0; q < 2; ++q) { const int row = row0 + q * NGW; ok[q] = row < M; rowv[q] = ok[q] ? row : row0;
            const bf16* qp = QRAW + (size_t)rowv[q] * 1536 + h * 192 + 8 * s; const bf16* kp = KV + (size_t)rowv[q] * KVP + h * 320 + 8 * s;
#pragma unroll
            for (int j = 0; j < 3; ++j) qw[q][j] = *(const v4u*)(qp + 64 * j);
#pragma unroll
            for (int j = 0; j < 2; ++j) kw[q][j] = *(const v4u*)(kp + 64 * j);
            kp0[q] = *(const f32x4*)(KPE + (size_t)rowv[q] * 64 + 8 * s); kp1[q] = *(const f32x4*)(KPE + (size_t)rowv[q] * 64 + 8 * s + 4);
            c0[q] = *(const f32x4*)(ROPE + (size_t)rowv[q] * 64 + 8 * (s & 3)); c1[q] = *(const f32x4*)(ROPE + (size_t)rowv[q] * 64 + 8 * (s & 3) + 4);
            s0[q] = *(const f32x4*)(ROPE + (size_t)rowv[q] * 64 + 32 + 8 * (s & 3)); s1[q] = *(const f32x4*)(ROPE + (size_t)rowv[q] * 64 + 32 + 8 * (s & 3) + 4); }
#pragma unroll
        for (int q = 0; q < 2; ++q) {
            {
                float v[3][8]; float ss = 0.f;
#pragma unroll
                for (int j = 0; j < 3; ++j)
#pragma unroll
                    for (int e = 0; e < 4; ++e) { v[j][2 * e] = bflo(qw[q][j][e]); v[j][2 * e + 1] = bfhi(qw[q][j][e]); ss += v[j][2 * e] * v[j][2 * e] + v[j][2 * e + 1] * v[j][2 * e + 1]; }
                ss += __shfl_xor(ss, 1); ss += __shfl_xor(ss, 2); ss += __shfl_xor(ss, 4);
                const float rstd = 1.0f / sqrtf(ss * (1.0f / 192.0f) + EPS);
#pragma unroll
                for (int j = 0; j < 3; ++j)
#pragma unroll
                    for (int e = 0; e < 8; ++e) v[j][e] *= rstd * ((e < 4) ? gq[2 * j][e & 3] : gq[2 * j + 1][e & 3]);
#pragma unroll
                for (int e = 0; e < 8; ++e) { const float other = __shfl_xor(v[2][e], 4); const float c = (e < 4) ? c0[q][e & 3] : c1[q][e & 3], sn = (e < 4) ? s0[q][e & 3] : s1[q][e & 3]; v[2][e] = v[2][e] * c + sgn * other * sn; }
                if (ok[q]) { bf16* qp = QRAW + (size_t)rowv[q] * 1536 + h * 192 + 8 * s;
#pragma unroll
                    for (int j = 0; j < 3; ++j) { v4u o; o.x = cvtpk(v[j][0], v[j][1]); o.y = cvtpk(v[j][2], v[j][3]); o.z = cvtpk(v[j][4], v[j][5]); o.w = cvtpk(v[j][6], v[j][7]); *(v4u*)(qp + 64 * j) = o; } }
            }
            {
                float v[3][8]; float ss = 0.f;
#pragma unroll
                for (int j = 0; j < 2; ++j)
#pragma unroll
                    for (int e = 0; e < 4; ++e) { v[j][2 * e] = bflo(kw[q][j][e]); v[j][2 * e + 1] = bfhi(kw[q][j][e]); ss += v[j][2 * e] * v[j][2 * e] + v[j][2 * e + 1] * v[j][2 * e + 1]; }
#pragma unroll
                for (int e = 0; e < 4; ++e) { v[2][e] = kp0[q][e]; v[2][4 + e] = kp1[q][e]; }
                ss += pg8::dot4(kp0[q]) + pg8::dot4(kp1[q]);
                ss += __shfl_xor(ss, 1); ss += __shfl_xor(ss, 2); ss += __shfl_xor(ss, 4);
                const float rstd = 1.0f / sqrtf(ss * (1.0f / 192.0f) + EPS);
#pragma unroll
                for (int j = 0; j < 3; ++j)
#pragma unroll
                    for (int e = 0; e < 8; ++e) v[j][e] *= rstd * ((e < 4) ? gk[2 * j][e & 3] : gk[2 * j + 1][e & 3]);
#pragma unroll
                for (int e = 0; e < 8; ++e) { const float other = __shfl_xor(v[2][e], 4); const float c = (e < 4) ? c0[q][e & 3] : c1[q][e & 3], sn = (e < 4) ? s0[q][e & 3] : s1[q][e & 3]; v[2][e] = v[2][e] * c + sgn * other * sn; }
                if (ok[q]) { bf16* kp = KV + (size_t)rowv[q] * KVP + h * 320 + 8 * s;
#pragma unroll
                    for (int j = 0; j < 3; ++j) { v4u o; o.x = cvtpk(v[j][0], v[j][1]); o.y = cvtpk(v[j][2], v[j][3]); o.z = cvtpk(v[j][4], v[j][5]); o.w = cvtpk(v[j][6], v[j][7]); *(v4u*)(kp + 64 * j) = o; } }
            }
        }
    }
}
__device__ __forceinline__ void ph_final_xk(Frame& F) {
    const int gw = F.vcu * NWAVES + F.wave, NGW = F.G * NWAVES, lane = lane_id(), h = lane >> 4, s = lane & 15;
    bf16* XKV = (bf16*)(F.ws + WS_XKV); const float* g = F.in[24];
    const f32x4 g0 = *(const f32x4*)(g + 8 * s), g1 = *(const f32x4*)(g + 8 * s + 4);
    GW_LOOP(row, MMEM) {
        bf16* kp = XKV + (size_t)row * 1024 + h * 256 + 8 * s;
        const v4u w = *(const v4u*)kp; float v[8]; float ss = 0.f;
#pragma unroll
        for (int e = 0; e < 4; ++e) { v[2 * e] = bflo(w[e]); v[2 * e + 1] = bfhi(w[e]); ss += v[2 * e] * v[2 * e] + v[2 * e + 1] * v[2 * e + 1]; }
        ss += __shfl_xor(ss, 1); ss += __shfl_xor(ss, 2); ss += __shfl_xor(ss, 4); ss += __shfl_xor(ss, 8);
        const float rstd = 1.0f / sqrtf(ss * (1.0f / 128.0f) + EPS);
        v4u o; o.x = cvtpk(v[0] * rstd * g0[0], v[1] * rstd * g0[1]); o.y = cvtpk(v[2] * rstd * g0[2], v[3] * rstd * g0[3]);
        o.z = cvtpk(v[4] * rstd * g1[0], v[5] * rstd * g1[1]); o.w = cvtpk(v[6] * rstd * g1[2], v[7] * rstd * g1[3]);
        *(v4u*)kp = o;
    }
}

typedef float f32x2 __attribute__((ext_vector_type(2)));
struct HgaIn { f32x2 lf[8]; unsigned hq[8]; bf16x8 v0, v1; };
__device__ __forceinline__ void hg_a_load(Frame& F, int item, HgaIn& in, int tid) {
    const int bh = item >> 5, c = item & 31, b = bh >> 3, h = bh & 7, seg = tid >> 6, k2 = tid & 63;
    const size_t row0 = (size_t)b * SEQ + (size_t)c * 64; const int hcol = h * 128;
    const bf16* HQ = (const bf16*)(F.ws + WS_HQ); const float* LF = (const float*)(F.ws + WS_LF); const bf16* HI = (const bf16*)(F.ws + WS_HI);
#pragma unroll
    for (int i = 0; i < 8; ++i) { const size_t e = (row0 + seg * 8 + i) * 1024 + hcol + 2 * k2; in.lf[i] = __builtin_nontemporal_load((const f32x2*)(LF + e)); in.hq[i] = __builtin_nontemporal_load((const unsigned*)(HQ + e)); }
    const int sr = tid >> 4, sc = (tid & 15) * 8;
    in.v0 = __builtin_nontemporal_load((const bf16x8*)(HI + (row0 + sr) * 1024 + hcol + sc)); in.v1 = __builtin_nontemporal_load((const bf16x8*)(HI + (row0 + 32 + sr) * 1024 + hcol + sc));
}
__device__ __forceinline__ void ph_hg_a(Frame& F) {
    using namespace att;
    int tid = (F.wave * 64 + lane_id()); asm volatile("" : "+v"(tid));
    const int lane = tid & 63, wid = F.wave, r32 = lane & 31, hi = lane >> 5;
    bf16* OINTRA = (bf16*)F.out; bf16* QT = (bf16*)F.out + (size_t)M * 1024;
    bf16* DSB = (bf16*)(F.ws + WS_DS); float* DV = (float*)(F.ws + WS_DV);
    char* QtL = F.ldsg; char* KtL = F.ldsg + 16384; char* VL = F.ldsg + 32768; char* KdT = F.ldsg + 49152; float* tot = (float*)(F.ldsg + 49152 + 18432);
    int item = F.vcu; if (item >= 1024) return;
    HgaIn in; hg_a_load(F, item, in, tid);
    for (; item < 1024; item += F.G) {
        const int bh = item >> 5, c = item & 31, b = bh >> 3, h = bh & 7;
        const size_t row0 = (size_t)b * SEQ + (size_t)c * 64; const int hcol = h * 128;
        {
            const int seg = tid >> 6, k2 = tid & 63;
            f32x2 cs[8]; f32x2 run = {0.f, 0.f};
#pragma unroll
            for (int i = 0; i < 8; ++i) { run += in.lf[i]; cs[i] = run; }
            *(f32x2*)(tot + seg * 128 + 2 * k2) = run;
            __syncthreads();
            f32x2 pre = {0.f, 0.f}, blast = {0.f, 0.f};
#pragma unroll
            for (int s2 = 0; s2 < 8; ++s2) { const f32x2 tv = *(const f32x2*)(tot + s2 * 128 + 2 * k2); if (s2 < seg) pre += tv; blast += tv; }
            float kd[2][8];
#pragma unroll
            for (int i = 0; i < 8; ++i) { const int t = seg * 8 + i; float qt[2], kt[2];
#pragma unroll
                for (int e = 0; e < 2; ++e) { const float bb = pre[e] + cs[i][e]; const float fv = __expf(in.lf[i][e]); const float kk = 1.0f - fv; const float qv = e ? bfhi(in.hq[i]) : bflo(in.hq[i]);
                    qt[e] = qv * __expf(bb); kt[e] = kk * __expf(-bb); kd[e][i] = kk * __expf(blast[e] - bb); }
                const unsigned qw = cvtpk(qt[0], qt[1]);
                *(unsigned*)(QT + (row0 + t) * 1024 + hcol + 2 * k2) = qw;
                *(unsigned*)(QtL + kswz<128>(t, 4 * k2)) = qw; *(unsigned*)(KtL + kswz<128>(t, 4 * k2)) = cvtpk(kt[0], kt[1]); }
#pragma unroll
            for (int e = 0; e < 2; ++e) *(v4u*)(KdT + (2 * k2 + e) * 144 + seg * 16) = (v4u){cvtpk(kd[e][0], kd[e][1]), cvtpk(kd[e][2], kd[e][3]), cvtpk(kd[e][4], kd[e][5]), cvtpk(kd[e][6], kd[e][7])};
            if (seg == 0) *(f32x2*)(DV + (size_t)item * 128 + 2 * k2) = (f32x2){__expf(blast[0]), __expf(blast[1])};
            const int sr = tid >> 4, sc = (tid & 15) * 8;
            *(bf16x8*)(VL + v_st(sr, sc)) = in.v0; *(bf16x8*)(VL + v_st(32 + sr, sc)) = in.v1;
        }
        __syncthreads();
        if (item + F.G < 1024) hg_a_load(F, item + F.G, in, tid);
        const int vb = (int)(uintptr_t)VL + v_rd_base(lane);
        {
            const int rh = wid & 1, dq = wid >> 1;
            bf16x8 qr[8];
#pragma unroll
            for (int d0 = 0; d0 < 8; ++d0) qr[d0] = *(const bf16x8*)(QtL + kswz<128>(32 * rh + r32, (16 * d0 + 8 * hi) * 2));
            f32x16 p0, p1; qkt<128>(p0, p1, KtL, qr, r32, hi);
            const int tt = 32 * rh + r32;
#pragma unroll
            for (int r = 0; r < 16; ++r) { const int sk = crow(r, hi); if (sk > tt) p0[r] = 0.f; if (sk + 32 > tt) p1[r] = 0.f; }
            bf16x8 pa0, pa1, pa2, pa3; pack_p(p0, p1, pa0, pa1, pa2, pa3);
            f32x16 od = {}; pv_one<0>(od, vb + dq * 512, pa0, pa1, pa2, pa3);
#pragma unroll
            for (int r = 0; r < 16; ++r) OINTRA[(row0 + 32 * rh + crow(r, hi)) * 1024 + hcol + 32 * dq + r32] = (bf16)(cvtpk(od[r], 0.f) & 0xffffu);
        }
        {
            const int d0 = wid & 3, kh = wid >> 2, vbb = vb + d0 * 512;
            const s16x4 l0 = tr_read<v_rd_off(0, 0, 0)>(vbb), h0 = tr_read<v_rd_off(0, 0, 1)>(vbb), l1 = tr_read<v_rd_off(0, 1, 0)>(vbb), h1 = tr_read<v_rd_off(0, 1, 1)>(vbb);
            const s16x4 l2 = tr_read<v_rd_off(0, 2, 0)>(vbb), h2 = tr_read<v_rd_off(0, 2, 1)>(vbb), l3 = tr_read<v_rd_off(0, 3, 0)>(vbb), h3 = tr_read<v_rd_off(0, 3, 1)>(vbb);
            asm volatile("s_waitcnt lgkmcnt(0)" ::: "memory"); SBAR();
#pragma unroll
            for (int kb = 0; kb < 2; ++kb) {
                const int kcol = 64 * kh + 32 * kb + r32; const char* kp = KdT + kcol * 144 + hi * 16;
                f32x16 acc = {};
                acc = __builtin_amdgcn_mfma_f32_32x32x16_bf16(ATT_PK(l0, h0), *(const bf16x8*)(kp), acc, 0, 0, 0);
                acc = __builtin_amdgcn_mfma_f32_32x32x16_bf16(ATT_PK(l1, h1), *(const bf16x8*)(kp + 32), acc, 0, 0, 0);
                acc = __builtin_amdgcn_mfma_f32_32x32x16_bf16(ATT_PK(l2, h2), *(const bf16x8*)(kp + 64), acc, 0, 0, 0);
                acc = __builtin_amdgcn_mfma_f32_32x32x16_bf16(ATT_PK(l3, h3), *(const bf16x8*)(kp + 96), acc, 0, 0, 0);
#pragma unroll
                for (int r = 0; r < 16; ++r) DSB[(size_t)item * 16384 + (size_t)(32 * d0 + crow(r, hi)) * 128 + 64 * kh + 32 * kb + r32] = (bf16)(cvtpk(acc[r], 0.f) & 0xffffu);
            }
        }
        __syncthreads();
    }
}
__device__ __forceinline__ void ph_hg_b(Frame& F) {
    const bf16* DSB = (const bf16*)(F.ws + WS_DS); const float* DV = (const float*)(F.ws + WS_DV); bf16* STB = (bf16*)(F.ws + WS_LF);
    for (int idx = F.vcu * 512 + (F.wave * 64 + lane_id()); idx < 32 * 4096; idx += F.G * 512) {
        const int bh = idx >> 12, e = idx & 4095, v = e >> 5, k4 = (e & 31) * 4;
        f32x4 st = {0.f, 0.f, 0.f, 0.f};
        for (int c0 = 0; c0 < 32; c0 += 8) {
            f32x4 ds[8], dd[8];
#pragma unroll
            for (int j = 0; j < 8; ++j) { const size_t item = (size_t)bh * 32 + c0 + j; const unsigned long long w = __builtin_nontemporal_load((const unsigned long long*)(DSB + item * 16384 + v * 128 + k4));
                ds[j] = (f32x4){bflo((unsigned)w), bfhi((unsigned)w), bflo((unsigned)(w >> 32)), bfhi((unsigned)(w >> 32))}; dd[j] = *(const f32x4*)(DV + item * 128 + k4); }
#pragma unroll
            for (int j = 0; j < 8; ++j) { const size_t item = (size_t)bh * 32 + c0 + j;
                *(unsigned long long*)(STB + item * 16384 + v * 128 + k4) = (unsigned long long)cvtpk(st[0], st[1]) | ((unsigned long long)cvtpk(st[2], st[3]) << 32);
                st = dd[j] * st + ds[j]; }
        }
    }
}
__device__ __forceinline__ void hg_c_unit(Frame& F, int unit) {
    using namespace att;
    const int bh = unit >> 3, c4 = unit & 7, b = bh >> 3, h = bh & 7, lane = lane_id(), wid = F.wave, r32 = lane & 31, hi = lane >> 5, tid = (F.wave * 64 + lane_id());
    const int ci = wid >> 1, rh = wid & 1, hcol = h * 128, lr = ci * 64 + 32 * rh + r32;
    const size_t row0 = (size_t)b * SEQ + (size_t)c4 * 256;
    const bf16* QT = (const bf16*)F.out + (size_t)M * 1024; const bf16* STB = (const bf16*)(F.ws + WS_LF); const bf16* OINTRA = (const bf16*)F.out;
    const bf16* HG = (const bf16*)(F.ws + WS_HG); bf16* MIX = (bf16*)(F.ws + WS_MIX); const float* gn = F.in[17];
    v4u t[16];
    { const bf16* src = STB + ((size_t)bh * 32 + c4 * 4) * 16384;
#pragma unroll
      for (int i = 0; i < 16; ++i) t[i] = __builtin_nontemporal_load((const v4u*)(src + (size_t)(tid + 512 * i) * 8)); }
    bf16x8 qf[8];
#pragma unroll
    for (int ks = 0; ks < 8; ++ks) qf[ks] = *(const bf16x8*)(QT + (row0 + lr) * 1024 + hcol + 16 * ks + 8 * hi);
#pragma unroll
    for (int i = 0; i < 16; ++i) { const int cidx = tid + 512 * i, cj = cidx >> 11, wi = cidx & 2047, v = wi >> 4, cc = wi & 15; *(v4u*)(F.ldsg + cj * 32768 + kswz<128>(v, cc * 16)) = t[i]; }
    __syncthreads();
    v4u gt[8], ot[8];
#pragma unroll
    for (int i = 0; i < 8; ++i) { const int p = tid + 512 * i, row = p >> 4, c16 = p & 15;
        gt[i] = __builtin_nontemporal_load((const v4u*)(HG + (row0 + row) * 1024 + hcol + c16 * 8)); ot[i] = __builtin_nontemporal_load((const v4u*)(OINTRA + (row0 + row) * 1024 + hcol + c16 * 8)); }
    const char* Sl = F.ldsg + ci * 32768;
    f32x16 acc[4];
#pragma unroll
    for (int d0 = 0; d0 < 4; ++d0) { acc[d0] = f32x16{};
#pragma unroll
        for (int ks = 0; ks < 8; ++ks) acc[d0] = __builtin_amdgcn_mfma_f32_32x32x16_bf16(*(const bf16x8*)(Sl + kswz<128>(32 * d0 + r32, (16 * ks + 8 * hi) * 2)), qf[ks], acc[d0], 0, 0, 0); }
    __syncthreads();
#pragma unroll
    for (int i = 0; i < 8; ++i) { const int p = tid + 512 * i, row = p >> 4, c16 = p & 15, off = row * 256 + ((c16 ^ (row & 15)) << 4);
        *(v4u*)(F.ldsg + off) = gt[i]; *(v4u*)(F.ldsg + 65536 + off) = ot[i]; }
    __syncthreads();
    char* my = F.ldsg + lr * 256 + 8 * hi; const int sw = lr & 15;
    float ss = 0.f;
#pragma unroll
    for (int d0 = 0; d0 < 4; ++d0)
#pragma unroll
        for (int g = 0; g < 4; ++g) { const unsigned long long ow = *(const unsigned long long*)(my + 65536 + (((4 * d0 + g) ^ sw) << 4));
            const f32x4 oi = {bflo((unsigned)ow), bfhi((unsigned)ow), bflo((unsigned)(ow >> 32)), bfhi((unsigned)(ow >> 32))};
#pragma unroll
            for (int i = 0; i < 4; ++i) { acc[d0][4 * g + i] += oi[i]; ss += acc[d0][4 * g + i] * acc[d0][4 * g + i]; } }
    ss += __shfl_xor(ss, 32);
    const float rstd = 1.0f / sqrtf(ss * (1.0f / 128.0f) + EPS);
#pragma unroll
    for (int d0 = 0; d0 < 4; ++d0)
#pragma unroll
        for (int g = 0; g < 4; ++g) { const int vc = 32 * d0 + 8 * g + 4 * hi; unsigned long long* gp = (unsigned long long*)(my + (((4 * d0 + g) ^ sw) << 4));
            const unsigned long long gw2 = *gp; const f32x4 gg = *(const f32x4*)(gn + vc);
            const float g0 = bflo((unsigned)gw2), g1 = bfhi((unsigned)gw2), g2 = bflo((unsigned)(gw2 >> 32)), g3 = bfhi((unsigned)(gw2 >> 32));
            const float o0 = acc[d0][4 * g + 0] * rstd * gg[0] * g0 * pg8::fsigmoid(g0), o1 = acc[d0][4 * g + 1] * rstd * gg[1] * g1 * pg8::fsigmoid(g1);
            const float o2 = acc[d0][4 * g + 2] * rstd * gg[2] * g2 * pg8::fsigmoid(g2), o3 = acc[d0][4 * g + 3] * rstd * gg[3] * g3 * pg8::fsigmoid(g3);
            *gp = (unsigned long long)cvtpk(o0, o1) | ((unsigned long long)cvtpk(o2, o3) << 32); }
    __syncthreads();
#pragma unroll
    for (int i = 0; i < 8; ++i) { const int p = tid + 512 * i, row = p >> 4, c16 = p & 15;
        *(v4u*)(MIX + (row0 + row) * 2048 + 1024 + hcol + c16 * 8) = *(const v4u*)(F.ldsg + row * 256 + ((c16 ^ (row & 15)) << 4)); }
    __syncthreads();
}

__device__ __forceinline__ void ph_combine(Frame& F) {
    const int gw = F.vcu * NWAVES + F.wave, NGW = F.G * NWAVES, lane = lane_id(), h = lane >> 3;
    bf16* MIX = (bf16*)(F.ws + WS_MIX); const bf16* P1 = (const bf16*)F.out + (size_t)M * 2048; const float* ML = (const float*)(F.ws + WS_KPE);
    float* RSO = (float*)(F.ws + WS_CTL) + CW_RS + RS_O * M;
    constexpr float C = att::ScaleMLA::S * 1.4426950408889634f;
    for (int row0 = gw; row0 < M; row0 += 2 * NGW) {
        v4u a0[2], a1[2], b0[2], b1[2]; float m0[2], l0[2], m1[2], l1[2]; int rowv[2]; bool ok[2];
#pragma unroll
        for (int q = 0; q < 2; ++q) { const int row = row0 + q * NGW; ok[q] = row < M; rowv[q] = ok[q] ? row : row0;
            a0[q] = __builtin_nontemporal_load((const v4u*)(MIX + (size_t)rowv[q] * 2048 + lane * 16)); a1[q] = __builtin_nontemporal_load((const v4u*)(MIX + (size_t)rowv[q] * 2048 + lane * 16 + 8));
            b0[q] = __builtin_nontemporal_load((const v4u*)(P1 + (size_t)rowv[q] * 1024 + lane * 16)); b1[q] = __builtin_nontemporal_load((const v4u*)(P1 + (size_t)rowv[q] * 1024 + lane * 16 + 8));
            m0[q] = ML[((size_t)rowv[q] * 8 + h) * 2]; l0[q] = ML[((size_t)rowv[q] * 8 + h) * 2 + 1]; m1[q] = ML[(((size_t)M + rowv[q]) * 8 + h) * 2]; l1[q] = ML[(((size_t)M + rowv[q]) * 8 + h) * 2 + 1]; }
#pragma unroll
        for (int q = 0; q < 2; ++q) {
            const float mm = fmaxf(m0[q], m1[q]); const float w0 = l0[q] * __builtin_amdgcn_exp2f((m0[q] - mm) * C), w1 = l1[q] * __builtin_amdgcn_exp2f((m1[q] - mm) * C);
            const float inv = 1.0f / (w0 + w1), c0 = w0 * inv, c1 = w1 * inv; float ss = 0.f; v4u o0, o1;
#pragma unroll
            for (int e = 0; e < 4; ++e) { const float x0 = c0 * bflo(a0[q][e]) + c1 * bflo(b0[q][e]), x1 = c0 * bfhi(a0[q][e]) + c1 * bfhi(b0[q][e]), y0 = c0 * bflo(a1[q][e]) + c1 * bflo(b1[q][e]), y1 = c0 * bfhi(a1[q][e]) + c1 * bfhi(b1[q][e]);
                ss += x0 * x0 + x1 * x1 + y0 * y0 + y1 * y1; o0[e] = cvtpk(x0, x1); o1[e] = cvtpk(y0, y1); }
            ss = wave_sum(ss);
            if (ok[q]) { *(v4u*)(MIX + (size_t)rowv[q] * 2048 + lane * 16) = o0; *(v4u*)(MIX + (size_t)rowv[q] * 2048 + lane * 16 + 8) = o1; if (lane == 0) RSO[rowv[q]] = ss; }
        }
    }
}

struct Args { const float* in[30]; float* out; unsigned char* ws; unsigned phmask; unsigned use_bar; };
__global__ void __launch_bounds__(NWAVES * 64, 2) mk_fwd(Args args) {
    extern __shared__ __attribute__((aligned(16))) unsigned char lds[];
    Frame F;
    F.lds = (LAS unsigned char*)lds; F.ldsg = (char*)lds;
    F.wave = __builtin_amdgcn_readfirstlane((int)threadIdx.x >> 6);
    F.G = gridDim.x; { const int bx = blockIdx.x; F.vcu = (F.G % 8 == 0) ? (bx % 8) * (F.G / 8) + bx / 8 : bx; }
#pragma unroll
    for (int i = 0; i < 30; ++i) F.in[i] = args.in[i];
    F.out = args.out; F.ws = args.ws;
    unsigned char* ws = args.ws;
    gu32* ctl = (gu32*)(ws + WS_CTL);
    for (int u = F.wave * 64 + lane_id(); u < (LDS_BYTES - LDSCTL_OFF) / 4; u += NWAVES * 64) ((LAS unsigned*)(F.lds + LDSCTL_OFF))[u] = 0u;
    __syncthreads();
    volatile LAS unsigned* MISC = (volatile LAS unsigned*)(F.lds + MISC_OFF);
#if defined(MK_TS_FROM) && (MK_TS_FROM == -1)
    if (blockIdx.x == 0 && (F.wave * 64 + lane_id()) == 0) { const unsigned long long t_ = __builtin_amdgcn_s_memrealtime(); MISC[16] = (unsigned)t_; MISC[17] = (unsigned)(t_ >> 32); }
#endif
    XcdBarrier bar; bar.bar = (unsigned*)(ctl + CW_BAR); bar.x = 0; bar.st = nullptr;
    if (args.use_bar) bar = xcd_barrier_post((unsigned*)(ctl + CW_BAR), MISC + 8, F.wave);
    float* RS = (float*)(ctl + CW_RS);
    bf16* XB = (bf16*)(ws + WS_XB); bf16* ACT = (bf16*)(ws + WS_ACT); bf16* MIX = (bf16*)(ws + WS_MIX);
    const unsigned phmask = args.phmask;
    bool pending = false;
#ifdef MK_TS_FROM
#define TS_HOOK(p) do { if (blockIdx.x == 0 && (F.wave * 64 + lane_id()) == 0) { if ((p) == MK_TS_FROM) { const unsigned long long t_ = __builtin_amdgcn_s_memrealtime(); MISC[16] = (unsigned)t_; MISC[17] = (unsigned)(t_ >> 32); } \
    if ((p) == MK_TS_TO + 1) { const unsigned long long t_ = __builtin_amdgcn_s_memrealtime(); MISC[18] = (unsigned)t_; MISC[19] = (unsigned)(t_ >> 32); } } } while (0)
#else
#define TS_HOOK(p) do { } while (0)
#endif
#define PHASE_BEGIN(p) if (((MK_CMASK >> (p)) & 1u) && (phmask & (1u << (p)))) { for (int rr_ = 0; rr_ <= (((p) == MK_REP_PHASE) ? MK_REP_COUNT : 0); ++rr_) { if (pending) { xcd_barrier(bar, F.wave); pending = false; } TS_HOOK(p);
#define PHASE_END(p) __syncthreads(); if (args.use_bar && (!((NOBAR_AFTER >> (p)) & 1u) || ((p) == MK_REP_PHASE && rr_ < MK_REP_COUNT))) pending = true; } }

    PHASE_BEGIN(PH_PREP_FFN1) ph_prep_ffn1(F); PHASE_END(PH_PREP_FFN1)

    PHASE_BEGIN(PH_FFN1_GU) {
        pg8::Gemm g{XB, (const bf16*)(ws + WS_WGU), M, 2 * DFF, DM}; pg8::StaticOrder S; S.init(M, 2 * DFF, F.G, (int)blockIdx.x);
        pg8::EpiSwiglu<-1> E{ws};
        pg8::gemm_phase<pg8::EpiSwiglu<-1>, pg8::StaticOrder, true, true>(F.lds, g, S, E, F.wave);
        __syncthreads();
        { int wk, nwk; if (light_worker((M / 256) * (2 * DFF / 256), F.G, (int)blockIdx.x, wk, nwk)) tail_job_a(F, wk, nwk); }
    } PHASE_END(PH_FFN1_GU)
#ifdef MK_XBAR
    if (args.use_bar) { for (int xb_ = 0; xb_ < MK_XBAR; ++xb_) xcd_barrier(bar, F.wave); }
#endif
    PHASE_BEGIN(PH_FFN1_DOWN) {
        pg8::Gemm g{ACT, (const bf16*)(ws + WS_WD), M, DM, DFF}; pg8::StaticOrder S; S.init(M, DM, F.G, (int)blockIdx.x);
        typedef pg8::EpiResid<RS_X1, 1, true, false> EpiT; EpiT E{ws, F.in[0], F.out};
        pg8::gemm_phase<EpiT, pg8::StaticOrder, true, true>(F.lds, g, S, E, F.wave);
    } PHASE_END(PH_FFN1_DOWN)
    PHASE_BEGIN(PH_WIN) {
        pg8::Gemm g{XB, (const bf16*)(ws + WS_WIN), M, INCP, DM}; pg8::StaticOrder S; S.init(M, INCP, F.G, (int)blockIdx.x);
        pg8::EpiWin E{ws};
        pg8::gemm_phase<pg8::EpiWin, pg8::StaticOrder, true, true>(F.lds, g, S, E, F.wave);
        __syncthreads();
        {
            pg8::Gemm g2{(const bf16*)(ws + WS_MEMN), (const bf16*)(ws + WS_WXKV), MMEM, 1024, DM}; pg8::StaticOrder S2; S2.init(MMEM, 1024, F.G, (int)((blockIdx.x + 16) % F.G));
            typedef pg8::EpiScaleBf16<WS_XKV, 1024, -1, 1> EpiT2; EpiT2 E2{ws};
            pg8::gemm_phase<EpiT2, pg8::StaticOrder, true, true>(F.lds, g2, S2, E2, F.wave);
            __syncthreads();
            if (F.G == 256) { int wk, nwk; if (light_worker((M / 256) * (INCP / 256), F.G, (int)blockIdx.x, wk, nwk) && (int)blockIdx.x < F.G - 16) tail_job_ffn2(F, wk, nwk - 16, 0, FFN2_SPLIT); }
            else tail_job_ffn2(F, (int)blockIdx.x, F.G, 0, FFN2_SPLIT);
        }
    } PHASE_END(PH_WIN)
    PHASE_BEGIN(PH_UP) {
        if (((blockIdx.x >> 3) & 1u) != 0u) { ph_hg_a(F); __syncthreads(); }
        { pg8::Gemm g{(const bf16*)(ws + WS_CQ), (const bf16*)(ws + WS_WQUP), M, 1536, 512}; pg8::StaticOrder S; S.init(M, 1536, F.G, (int)blockIdx.x);
          typedef pg8::EpiScaleBf16<WS_QRAW, 1536, RS_CQ, 512> EpiT; EpiT E{ws};
          pg8::gemm_phase<EpiT, pg8::StaticOrder, true, true>(F.lds, g, S, E, F.wave); }
        __syncthreads();
        { pg8::Gemm g{(const bf16*)(ws + WS_CKV), (const bf16*)(ws + WS_WKVUP), M, KVP, 256}; pg8::StaticOrder S; S.init(M, KVP, F.G, (int)((blockIdx.x + 64) % F.G));
          typedef pg8::EpiScaleBf16<WS_KV, KVP, RS_CKV, 256> EpiT; EpiT E{ws};
          pg8::gemm_phase<EpiT, pg8::StaticOrder, true, true>(F.lds, g, S, E, F.wave); }
        __syncthreads();
        if (((blockIdx.x >> 3) & 1u) == 0u) ph_hg_a(F);
    } PHASE_END(PH_UP)
    PHASE_BEGIN(PH_FINAL_QK) ph_final_qk(F); PHASE_END(PH_FINAL_QK)
    PHASE_BEGIN(PH_FINAL_XK) ph_final_xk(F); PHASE_END(PH_FINAL_XK)
    PHASE_BEGIN(PH_HG_B) ph_hg_b(F); PHASE_END(PH_HG_B)
    PHASE_BEGIN(PH_ATTN) {
        if (((blockIdx.x >> 3) & 1u) != 0u) { if (F.G == 256) hg_c_unit(F, F.vcu); else for (int u = F.vcu; u < 256; u += F.G) hg_c_unit(F, u); }
        {
            const att::bf16* Q = (const att::bf16*)(ws + WS_QRAW); const att::bf16* KVb = (const att::bf16*)(ws + WS_KV);
            float* ML = (float*)(ws + WS_KPE); att::bf16* P1 = (att::bf16*)F.out + (size_t)M * 2048;
            const int nsu = (F.G == 256) ? 2 : (512 + F.G - 1 - F.vcu) / F.G;
            for (int i = 0; i < nsu; ++i) {
                int bh, qb, part;
                if (F.G == 256) { const int s = F.vcu & 7, pr = s >> 1; bh = F.vcu >> 3; part = s & 1; qb = (i == 0) ? 7 - pr : pr; }
                else { const int su = F.vcu + i * F.G; bh = su >> 4; qb = (su >> 1) & 7; part = su & 1; }
                const int b = bh >> 3, h = bh & 7, NT = 4 * (qb + 1); const size_t r0 = (size_t)b * SEQ + (size_t)qb * 256;
                att::bf16* Ob = part ? P1 + r0 * 1024 + h * 128 : (att::bf16*)MIX + r0 * 2048 + h * 128;
                att::attn_body_p<192, 1536, KVP, true, att::ScaleMLA>(Q + r0 * 1536 + h * 192, KVb + (size_t)b * SEQ * KVP + h * 320, KVb + (size_t)b * SEQ * KVP + h * 320 + 192,
                    Ob, part ? 1024 : 2048, 64 * NT, part ? NT / 2 : 0, part ? NT : NT / 2, ML + (((size_t)part * M + r0) * 8 + h) * 2, 16, F.wave, F.ldsg);
            }
        }
        if (((blockIdx.x >> 3) & 1u) == 0u) { if (F.G == 256) hg_c_unit(F, F.vcu); else for (int u = F.vcu; u < 256; u += F.G) hg_c_unit(F, u); }
    } PHASE_END(PH_ATTN)
    PHASE_BEGIN(PH_COMBINE) ph_combine(F); PHASE_END(PH_COMBINE)
    PHASE_BEGIN(PH_WOUT) {
        pg8::Gemm g{MIX, (const bf16*)(ws + WS_WOUT), M, DM, DM}; pg8::StaticOrder S; S.init(M, DM, F.G, (int)blockIdx.x);
        typedef pg8::EpiResid<RS_X2, 2, false, false> EpiT; EpiT E{ws, nullptr, F.out}; pg8::MidScale Mh{16, ws};
        pg8::gemm_phase<EpiT, pg8::StaticOrder, true, true, pg8::MidScale>(F.lds, g, S, E, F.wave, Mh);
    } PHASE_END(PH_WOUT)
    PHASE_BEGIN(PH_XQ) {
        { pg8::Gemm g{XB, (const bf16*)(ws + WS_WXQ), M, 512, 1024, DM}; pg8::StaticOrder S; S.init(M, 512, F.G, (int)blockIdx.x);
          typedef pg8::EpiF32<WS_XQP, 512> EpiT; EpiT E{ws};
          pg8::gemm_phase<EpiT, pg8::StaticOrder, true, true>(F.lds, g, S, E, F.wave); }
        __syncthreads();
        { pg8::Gemm g{XB + 1024, (const bf16*)(ws + WS_WXQ) + 1024, M, 512, 1024, DM}; pg8::StaticOrder S; S.init(M, 512, F.G, (int)((blockIdx.x + F.G - 64) % F.G));
          typedef pg8::EpiF32<WS_XQP + (size_t)M * 512 * 4, 512> EpiT; EpiT E{ws};
          pg8::gemm_phase<EpiT, pg8::StaticOrder, true, true>(F.lds, g, S, E, F.wave); }
        __syncthreads();
        if ((int)blockIdx.x >= 128 || F.G != 256) { const int wk = (F.G == 256) ? (int)blockIdx.x - 128 : (int)blockIdx.x, nwk = (F.G == 256) ? 128 : F.G; tail_job_ffn2(F, wk, nwk, FFN2_SPLIT, 2 * I_FFN_G + I_FFN_D / 2); }
    } PHASE_END(PH_XQ)
    PHASE_BEGIN(PH_XATTN) {
        for (int u = F.vcu; u < 128; u += F.G) { const int bh = u >> 3, qb = u & 7, b = bh >> 2, h = bh & 3; const size_t r0 = (size_t)b * SEQ + (size_t)qb * 256;
            const float* Q = (const float*)(ws + WS_XQP); const att::bf16* KVb = (const att::bf16*)(ws + WS_XKV);
            att::attn_body<128, 512, 1024, 512, false, true, false, 2, att::ScaleX>(Q + r0 * 512 + h * 128, KVb + (size_t)b * MEML * 1024 + h * 256, KVb + (size_t)b * MEML * 1024 + h * 256 + 128,
                (att::bf16*)(ws + WS_XO) + r0 * 512 + h * 128, MEML, F.in[23], nullptr, F.wave, F.ldsg); }
        if (F.vcu >= 128 || F.G != 256) { const int wk = (F.G == 256) ? F.vcu - 128 : F.vcu, nwk = (F.G == 256) ? 128 : F.G; tail_job_ffn2(F, wk, nwk, 2 * I_FFN_G + I_FFN_D / 2, 3 * I_FFN_G); }
    } PHASE_END(PH_XATTN)
    PHASE_BEGIN(PH_XO) {
        pg8::Gemm g{(const bf16*)(ws + WS_XO), (const bf16*)(ws + WS_WXO), M, DM, 512}; pg8::StaticOrder S; S.init(M, DM, F.G, (int)blockIdx.x);
        typedef pg8::EpiResid<RS_X3, 2, false, false> EpiT; EpiT E{ws, nullptr, F.out};
        pg8::gemm_phase<EpiT, pg8::StaticOrder, true, true>(F.lds, g, S, E, F.wave);
    } PHASE_END(PH_XO)
    PHASE_BEGIN(PH_FFN2_GU) {
        pg8::Gemm g{XB, (const bf16*)(ws + WS_W2GU), M, 2 * DFF, DM}; pg8::HalfTailOrder S; S.init(M, 2 * DFF, F.G, (int)blockIdx.x);
        pg8::EpiSwiglu<RS_X3> E{ws};
        pg8::gemm_phase<pg8::EpiSwiglu<RS_X3>, pg8::HalfTailOrder, true, true, pg8::NoMid, true>(F.lds, g, S, E, F.wave);
        __syncthreads();
    } PHASE_END(PH_FFN2_GU)
    PHASE_BEGIN(PH_FFN2_DOWN) {
        pg8::Gemm g{ACT, (const bf16*)(ws + WS_W2D), M, DM, DFF}; pg8::StaticOrder S; S.init(M, DM, F.G, (int)blockIdx.x);
        typedef pg8::EpiResid<-1, 1, false, true> EpiT; EpiT E{ws, nullptr, F.out};
        pg8::gemm_phase<EpiT, pg8::StaticOrder, true, true>(F.lds, g, S, E, F.wave);
    } PHASE_END(PH_FFN2_DOWN)
#ifdef MK_TS_FROM
    if (args.use_bar) { xcd_barrier(bar, F.wave); TS_HOOK(PH_COUNT);
        if (blockIdx.x == 0 && (F.wave * 64 + lane_id()) == 0) { const unsigned long long t0_ = ((unsigned long long)MISC[17] << 32) | MISC[16], t1_ = ((unsigned long long)MISC[19] << 32) | MISC[18];
            const float us_ = (float)(t1_ - t0_) * 0.01f; F.out[MK_TS_IDX] += (us_ - (float)(MK_TS_T0)) * (float)(MK_TS_SCALE); } }
#endif
#undef PHASE_BEGIN
#undef PHASE_END
}

#ifndef MK_SINGLE
#define MK_SINGLE 1
#endif
extern "C" void kernel_launch(void* const* d_in, const int* in_sizes, int n_in, void* d_out, int out_size, void* d_ws, size_t ws_size, hipStream_t stream) {
    static int grid = 0;
    if (grid == 0) {
        if (n_in != 30 || in_sizes[0] != M * DM || out_size != M * DM || ws_size < WS_END) { fprintf(stderr, "kernel_launch: unexpected shapes / workspace (%d inputs, ws %zu)\n", n_in, ws_size); grid = -1; return; }
        int dev = 0, cus = 0, per_cu = 0;
        if (hipGetDevice(&dev) != hipSuccess || hipDeviceGetAttribute(&cus, hipDeviceAttributeMultiprocessorCount, dev) != hipSuccess) { grid = -1; return; }
        if (hipFuncSetAttribute((const void*)mk_fwd, hipFuncAttributeMaxDynamicSharedMemorySize, LDS_BYTES) != hipSuccess) { fprintf(stderr, "kernel_launch: hipFuncSetAttribute failed\n"); grid = -1; return; }
        if (hipOccupancyMaxActiveBlocksPerMultiprocessor(&per_cu, (const void*)mk_fwd, NWAVES * 64, LDS_BYTES) != hipSuccess || per_cu < 1) { fprintf(stderr, "kernel_launch: occupancy query says %d blocks/CU\n", per_cu); }
        (void)hipGetLastError();
        grid = cus;
    }
    if (grid < 0) return;
    (void)hipMemsetAsync((char*)d_ws + WS_CTL, 0, CTL_ZERO_BYTES, stream);
    Args a{};
    for (int i = 0; i < 30; ++i) a.in[i] = (const float*)d_in[i];
    a.out = (float*)d_out; a.ws = (unsigned char*)d_ws;
    auto run_phases = [&](unsigned mask) {
        if (MK_SINGLE) { a.phmask = mask; a.use_bar = 1u; hipLaunchKernelGGL(mk_fwd, dim3(grid), dim3(NWAVES * 64), LDS_BYTES, stream, a); }
        else for (int p = 0; p < PH_COUNT; ++p) if (mask & (1u << p)) { a.phmask = 1u << p; a.use_bar = 0u; hipLaunchKernelGGL(mk_fwd, dim3(grid), dim3(NWAVES * 64), LDS_BYTES, stream, a); }
    };
    run_phases((1u << PH_COUNT) - 1u);
}
```
